# Optimizing an MI355X kernel written in HIP

```python
import jax, jax.numpy as jnp
from jax import lax
import numpy as np

D_MODEL = 1024
BATCH = 4
SEQ = 8192
DEPTH = 2
DEC_BATCH = 8
DEC_SEQ = 64
PAST_LEN = 4096

CHUNK = 64
WINDOW = 128
NB_PREV = WINDOW // CHUNK
BAND = (NB_PREV + 1) * CHUNK
HEAD_DIM = 64
D_ATTN = D_MODEL // 2
N_HEADS = D_ATTN // HEAD_DIM
N_KV = 2
REP = N_HEADS // N_KV
D_KV = N_KV * HEAD_DIM
D_GMLP = D_MODEL - D_ATTN
N_GROUPS = 8
GROUP_DIM = D_GMLP // N_GROUPS
TM_CHUNK = 128
D_MIX = D_ATTN + D_GMLP
D_IN = D_ATTN + 2 * D_KV + 2 * D_GMLP
D_FF = 2816
CONV_W = 3
EPS = 1e-6
NEG = -1e30

kernel_name = 'hymba_swa_sink_gmlp_convffn_stream'


def _rmsnorm(x, g):
    x32 = x.astype(jnp.float32)
    y = x32 * lax.rsqrt(jnp.mean(x32 * x32, axis=-1, keepdims=True) + EPS)
    return y.astype(x.dtype) * g


def _alibi(nq, nk, offset):
    slopes = jnp.exp2(-8.0 * jnp.arange(1, N_HEADS + 1, dtype=jnp.float32) / N_HEADS)
    dist = jnp.abs(offset + jnp.arange(nq)[:, None] - jnp.arange(nk)[None, :]).astype(jnp.float32)
    return -slopes.reshape(N_KV, REP, 1, 1) * dist


def _sink_attend(q, k, v, bias, sinks):
    s = jnp.einsum('...qkrd,...skd->...krqs', q, k).astype(jnp.float32) * (HEAD_DIM ** -0.5) + bias
    sink = sinks.astype(jnp.float32).reshape(N_KV, REP, 1, 1)
    m = jnp.maximum(jnp.max(s, axis=-1, keepdims=True), sink)
    e = jnp.exp(s - m)
    p = e / (jnp.sum(e, axis=-1, keepdims=True) + jnp.exp(sink - m))
    return jnp.einsum('...krqs,...skd->...qkrd', p.astype(v.dtype), v)


def _swa_prompt(q, k, v, sinks):
    b, s = q.shape[:2]
    nc = s // CHUNK
    qb = q.reshape(b, nc, CHUNK, N_KV, REP, HEAD_DIM)

    def band(t):
        tp = jnp.pad(t, ((0, 0), (WINDOW, 0), (0, 0), (0, 0)))
        tp = tp.reshape(b, nc + NB_PREV, CHUNK, N_KV, HEAD_DIM)
        return jnp.concatenate([tp[:, j:j + nc] for j in range(NB_PREV + 1)], axis=2)

    key_pos = (jnp.arange(nc)[:, None] - NB_PREV) * CHUNK + jnp.arange(BAND)[None, :]
    mask = jnp.where(key_pos >= 0, 0.0, NEG).astype(jnp.float32)[:, None, None, None, :]
    bias = _alibi(CHUNK, BAND, WINDOW) + mask
    o = _sink_attend(qb, band(k), band(v), bias, sinks)
    return o.reshape(b, s, D_ATTN)


def _swa_sample(q, k, v, cache_k, cache_v, sinks):
    b, n = q.shape[:2]
    r = cache_k.shape[1]
    kk = jnp.concatenate([cache_k.astype(k.dtype), k], axis=1)
    vv = jnp.concatenate([cache_v.astype(v.dtype), v], axis=1)
    o = _sink_attend(q.reshape(b, n, N_KV, REP, HEAD_DIM), kk, vv, _alibi(n, r + n, r), sinks)
    return o.reshape(b, n, D_ATTN), kk[:, -r:], vv[:, -r:]


def _gmlp_pre(zp, v_g):
    z = jax.nn.gelu(zp)
    u, v = jnp.split(z, 2, axis=-1)
    lead = u.shape[:-1]
    v = _rmsnorm(v.reshape(*lead, N_GROUPS, GROUP_DIM), v_g.reshape(N_GROUPS, GROUP_DIM))
    return u.reshape(*lead, N_GROUPS, GROUP_DIM), v


def _tm_mask():
    i = jnp.arange(TM_CHUNK)
    return (i[None, :] // CHUNK) <= (i[:, None] // CHUNK)


def _gmlp_prompt(u, v, ws, bias):
    b, s = u.shape[:2]
    nc = s // TM_CHUNK
    ws_m = jnp.where(_tm_mask()[None], ws, 0.0)
    vb = v.reshape(b, nc, TM_CHUNK, N_GROUPS, GROUP_DIM)
    sp = jnp.einsum('gij,bcjgd->bcigd', ws_m, vb) + bias.T[:, :, None]
    return (u.reshape(b, nc, TM_CHUNK, N_GROUPS, GROUP_DIM) * sp).reshape(b, s, D_GMLP)


def _gmlp_sample(u, v, ws, bias):
    b, n = u.shape[:2]
    ws_m = jnp.where(_tm_mask()[:n, :n][None], ws[:, :n, :n], 0.0)
    sp = jnp.einsum('gij,bjgd->bigd', ws_m, v) + bias[:, :n].T[:, :, None]
    return (u * sp).reshape(b, n, D_GMLP), v.reshape(b, n, D_GMLP)


def _split_in(p):
    q, k, v, z = jnp.split(p, [D_ATTN, D_ATTN + D_KV, D_ATTN + 2 * D_KV], axis=-1)
    lead = q.shape[:-1]
    return q, k.reshape(*lead, N_KV, HEAD_DIM), v.reshape(*lead, N_KV, HEAD_DIM), z


def _mix_out(a, m, g_a, g_m, w_out):
    return jnp.concatenate([_rmsnorm(a, g_a), _rmsnorm(m, g_m)], axis=-1) @ w_out


def _conv_ffn(h, prev, w_up, w_gate, conv_w, conv_b, w_down):
    a = h @ w_up
    g = h @ w_gate
    ap = jnp.concatenate([prev.astype(a.dtype), a], axis=1)
    t = a.shape[1]
    c = conv_b
    for j in range(CONV_W):
        c = c + ap[:, j:j + t] * conv_w[j]
    y = (jax.nn.gelu(c) * g) @ w_down
    return y, ap[:, -(CONV_W - 1):]


def setup_inputs(seed: int = 0) -> dict:
    key = jax.random.key(seed)
    ks = jax.random.split(key, 24)
    f = jnp.float32
    r = min(WINDOW, PAST_LEN)
    nrm = lambda k, shape, s: jax.random.normal(k, shape, f) * s
    return {
        'x_prompt': nrm(ks[0], (BATCH, SEQ, D_MODEL), 1.0),
        'x_sample': nrm(ks[1], (DEC_BATCH, DEC_SEQ, D_MODEL), 1.0),
        'cache_swa_k': nrm(ks[2], (DEPTH, DEC_BATCH, r, N_KV, HEAD_DIM), 1.0),
        'cache_swa_v': nrm(ks[3], (DEPTH, DEC_BATCH, r, N_KV, HEAD_DIM), 1.0),
        'cache_ffn_conv': nrm(ks[4], (DEPTH, DEC_BATCH, CONV_W - 1, D_FF), 1.0),
        'norm1_g': 1.0 + nrm(ks[5], (DEPTH, D_MODEL), 0.02),
        'w_in': nrm(ks[6], (DEPTH, D_MODEL, D_IN), D_MODEL ** -0.5),
        'attn_sinks': nrm(ks[7], (DEPTH, N_HEADS), 0.5),
        'gmlp_v_g': 1.0 + nrm(ks[8], (DEPTH, D_GMLP), 0.02),
        'gmlp_ws': nrm(ks[9], (DEPTH, N_GROUPS, TM_CHUNK, TM_CHUNK), TM_CHUNK ** -0.5),
        'gmlp_b': 1.0 + nrm(ks[10], (DEPTH, N_GROUPS, TM_CHUNK), 0.1),
        'attn_out_g': 1.0 + nrm(ks[11], (DEPTH, D_ATTN), 0.02),
        'gmlp_out_g': 1.0 + nrm(ks[12], (DEPTH, D_GMLP), 0.02),
        'w_out': nrm(ks[13], (DEPTH, D_MIX, D_MODEL), D_MIX ** -0.5),
        'norm2_g': 1.0 + nrm(ks[14], (DEPTH, D_MODEL), 0.02),
        'w_up': nrm(ks[15], (DEPTH, D_MODEL, D_FF), D_MODEL ** -0.5),
        'w_gate': nrm(ks[16], (DEPTH, D_MODEL, D_FF), D_MODEL ** -0.5),
        'conv_w': nrm(ks[17], (DEPTH, CONV_W, D_FF), CONV_W ** -0.5),
        'conv_b': nrm(ks[18], (DEPTH, D_FF), 0.01),
        'w_down': nrm(ks[19], (DEPTH, D_FF, D_MODEL), D_FF ** -0.5),
        'final_g': 1.0 + nrm(ks[20], (D_MODEL,), 0.02),
    }


def reference(x_prompt, x_sample, cache_swa_k, cache_swa_v, cache_ffn_conv, norm1_g, w_in,
              attn_sinks, gmlp_v_g, gmlp_ws, gmlp_b, attn_out_g, gmlp_out_g, w_out, norm2_g,
              w_up, w_gate, conv_w, conv_b, w_down, final_g):
    xp, xs = x_prompt, x_sample
    bp = xp.shape[0]
    pk, pv, pc, sk, sv, sc, sg = [], [], [], [], [], [], []
    for l in range(DEPTH):
        q, k, v, z = _split_in(_rmsnorm(xp, norm1_g[l]) @ w_in[l])
        a = _swa_prompt(q, k, v, attn_sinks[l])
        u, gv = _gmlp_pre(z, gmlp_v_g[l])
        m = _gmlp_prompt(u, gv, gmlp_ws[l], gmlp_b[l])
        xp = xp + _mix_out(a, m, attn_out_g[l], gmlp_out_g[l], w_out[l])
        y, c_st = _conv_ffn(_rmsnorm(xp, norm2_g[l]), jnp.zeros((bp, CONV_W - 1, D_FF), xp.dtype),
                            w_up[l], w_gate[l], conv_w[l], conv_b[l], w_down[l])
        xp = xp + y
        pk.append(k[:, -WINDOW:])
        pv.append(v[:, -WINDOW:])
        pc.append(c_st)
        q, k, v, z = _split_in(_rmsnorm(xs, norm1_g[l]) @ w_in[l])
        a, nk, nv = _swa_sample(q, k, v, cache_swa_k[l], cache_swa_v[l], attn_sinks[l])
        u, gv = _gmlp_pre(z, gmlp_v_g[l])
        m, g_st = _gmlp_sample(u, gv, gmlp_ws[l], gmlp_b[l])
        xs = xs + _mix_out(a, m, attn_out_g[l], gmlp_out_g[l], w_out[l])
        y, c_st = _conv_ffn(_rmsnorm(xs, norm2_g[l]), cache_ffn_conv[l],
                            w_up[l], w_gate[l], conv_w[l], conv_b[l], w_down[l])
        xs = xs + y
        sk.append(nk)
        sv.append(nv)
        sc.append(c_st)
        sg.append(g_st)
    y_prompt = _rmsnorm(xp, final_g)
    y_sample = _rmsnorm(xs, final_g)
    return (y_prompt, y_sample, jnp.stack(pk), jnp.stack(pv), jnp.stack(pc),
            jnp.stack(sk), jnp.stack(sv), jnp.stack(sc), jnp.stack(sg))
```

```cpp
#include <hip/hip_runtime.h>
#include <hip/hip_cooperative_groups.h>
#include <cstdio>
#include <cstdint>
namespace cg = cooperative_groups;
#define MK_MULTI 0
namespace pg8 {
#define PG8_LAS __attribute__((address_space(3)))
typedef unsigned short bf16_t;
typedef short bf16x8 __attribute__((ext_vector_type(8)));
typedef float f32x4 __attribute__((ext_vector_type(4)));
typedef unsigned u32x4 __attribute__((ext_vector_type(4)));
constexpr int BM = 256, BK = 64, HALF = 128, HTB = HALF * BK * 2  , STAGE_BYTES = 8 * HTB, NXCD = 8, WGM = 8;

__host__ __device__ __forceinline__ int lds_byte(int r, int c) { const int st = (r >> 4) * 2 + (c >> 5), rr = r & 15, cc = c & 31, ob = rr * 64 + cc * 2; return st * 1024 + (ob ^ (((ob >> 9) & 1) << 5)); }
__host__ __device__ __forceinline__ void stage_rc(int b, int& R, int& C) { const int st = b / 1024, sb = b % 1024, swz = sb ^ (((sb >> 9) & 1) << 5); R = (st >> 1) * 16 + swz / 64; C = (st & 1) * 32 + (swz % 64) / 2; }
__host__ __device__ __forceinline__ int perm32(int rho) { const int n = rho >> 4, i = rho & 15; return 8 * (i >> 2) + 4 * n + (i & 3); }

struct Unit { int pm, pn; };
struct Gemm { const bf16_t* A; const bf16_t* Bt; int M, N, K; };

struct StaticOrder {
    int nM, nN, nwg, G, c;
    __host__ __device__ void init(int M, int N, int G_, int c_) { nM = M / BM; nN = N / BM; nwg = nM * nN; G = G_; c = c_; }
    __host__ __device__ bool next(int i, Unit& u) const {
        const long L = (long)i * G + c; if (L >= nwg) return false;
        int wgid = (int)L; { const int q = nwg / NXCD, r = nwg % NXCD, xcd = wgid % NXCD, off = wgid / NXCD; wgid = (xcd < r ? xcd * (q + 1) : r * (q + 1) + (xcd - r) * q) + off; }
        const int nig = WGM * nN, gid = wgid / nig, fm = gid * WGM, gsz = (nM - fm) < WGM ? (nM - fm) : WGM;
        u.pm = fm + ((wgid % nig) % gsz); u.pn = (wgid % nig) / gsz; return true;
    }
    __device__ __forceinline__ void a_ready(const Unit&) const {}
    __device__ __forceinline__ void done(const Unit&) const {}
};

__device__ __forceinline__ unsigned cvt_pk_bf16(float lo, float hi) { unsigned r; asm volatile("v_cvt_pk_bf16_f32 %0, %1, %2" : "=v"(r) : "v"(lo), "v"(hi)); return r; }
typedef float f32x2 __attribute__((ext_vector_type(2)));
constexpr int MP = 32768, MS = 512, MT = MP + MS, DMODEL = 1024, DIN = 1792, DFF = 2816, SEQ = 8192, DSEQ = 64;
__device__ __forceinline__ float gelu_t(float x) {
    const float u = x * (1.0f + 0.044715f * x * x);
    const float e = __builtin_amdgcn_exp2f(u * (-2.0f * 0.7978845608f * 1.4426950409f));
    return x * __builtin_amdgcn_rcpf(1.0f + e);
}
__device__ __forceinline__ u32x4 pack8(f32x4 v0, f32x4 v1) { u32x4 w; w.x = cvt_pk_bf16(v0[0], v0[1]); w.y = cvt_pk_bf16(v0[2], v0[3]); w.z = cvt_pk_bf16(v1[0], v1[1]); w.w = cvt_pk_bf16(v1[2], v1[3]); return w; }
__device__ __forceinline__ f32x4 gelu4(f32x4 v) { return (f32x4){gelu_t(v[0]), gelu_t(v[1]), gelu_t(v[2]), gelu_t(v[3])}; }

struct EpiIn {
    static constexpr bool PERM = true, AFTER_DRAIN = false;
    bf16_t *Q, *Kb, *Vb, *U, *GV; float *pk, *pv, *sk, *sv;
    __device__ __forceinline__ void operator()(const f32x4 (&acc)[2][2][4][2], const Unit& u, int wr, int wc, int fr, int fq) const {
        const int row0 = u.pm * BM + wr * 64 + fr, pn = u.pn;
        const int cw = wc * 32 + 8 * fq;
#pragma unroll
        for (int ai = 0; ai < 2; ++ai)
#pragma unroll
            for (int m = 0; m < 4; ++m) {
                const int row = row0 + ai * HALF + m * 16;
#pragma unroll
                for (int bj = 0; bj < 2; ++bj) {
                    f32x4 v0 = acc[ai][bj][m][0], v1 = acc[ai][bj][m][1];
                    if (pn < 2) {
                        *(u32x4*)(Q + (size_t)row * 512 + pn * 256 + bj * HALF + cw) = pack8(v0, v1);
                    } else if (pn == 2) {
                        bf16_t* dst = bj == 0 ? Kb : Vb;
                        *(u32x4*)(dst + (size_t)row * 128 + cw) = pack8(v0, v1);
                        float* o = nullptr;
                        if (row < MP) { const int t = row & (SEQ - 1), b = row >> 13; if (t >= SEQ - 128) o = (bj == 0 ? pk : pv) + ((size_t)(b * 128 + (t - (SEQ - 128))) * 128 + cw); }
                        else { const int rs = row - MP, b = rs >> 6, i = rs & 63; o = (bj == 0 ? sk : sv) + ((size_t)(b * 128 + 64 + i) * 128 + cw); }
                        if (o) { *(f32x4*)o = v0; *(f32x4*)(o + 4) = v1; }
                    } else if (pn < 5) {
                        *(u32x4*)(U + (size_t)row * 512 + (pn - 3) * 256 + bj * HALF + cw) = pack8(gelu4(v0), gelu4(v1));
                    } else {
                        *(u32x4*)(GV + (size_t)row * 512 + (pn - 5) * 256 + bj * HALF + cw) = pack8(gelu4(v0), gelu4(v1));
                    }
                }
                asm volatile("" ::: "memory");
            }
    }
};
struct EpiRes {
    static constexpr bool PERM = false, AFTER_DRAIN = false;
    const float* bp; const float* bs; float* X;
    __device__ __forceinline__ void operator()(const f32x4 (&acc)[2][2][4][2], const Unit& u, int wr, int wc, int fr, int fq) const {
        const int row0 = u.pm * BM + wr * 64 + fr; const int col0 = u.pn * BM + wc * 32 + 4 * fq;
        const float* base = (u.pm * BM < MP) ? bp : bs - (size_t)MP * DMODEL;
#pragma unroll
        for (int ai = 0; ai < 2; ++ai)
#pragma unroll
            for (int m = 0; m < 4; ++m) {
                const size_t off = (size_t)(row0 + ai * HALF + m * 16) * DMODEL + col0;
#pragma unroll
                for (int bj = 0; bj < 2; ++bj)
#pragma unroll
                    for (int n = 0; n < 2; ++n) { const f32x4 b = *(const f32x4*)(base + off + bj * HALF + n * 16); *(f32x4*)(X + off + bj * HALF + n * 16) = b + acc[ai][bj][m][n]; }
                asm volatile("" ::: "memory");
            }
    }
};
struct EpiUG {
    static constexpr bool PERM = true, AFTER_DRAIN = false;
    bf16_t *AU, *GG; float *pc, *sc;
    __device__ __forceinline__ void operator()(const f32x4 (&acc)[2][2][4][2], const Unit& u, int wr, int wc, int fr, int fq) const {
        const int row0 = u.pm * BM + wr * 64 + fr; const bool up = u.pn < 11;
        bf16_t* dst = up ? AU : GG; const int colt = (up ? u.pn : u.pn - 11) * BM + wc * 32 + 8 * fq;
#pragma unroll
        for (int ai = 0; ai < 2; ++ai)
#pragma unroll
            for (int m = 0; m < 4; ++m) {
                const int row = row0 + ai * HALF + m * 16;
                float* o = nullptr;
                if (up) {
                    if (row < MP) { const int t = row & (SEQ - 1); if (t >= SEQ - 2) o = pc + (size_t)((row >> 13) * 2 + (t - (SEQ - 2))) * DFF; }
                    else { const int rs = row - MP, i = rs & 63; if (i >= 62) o = sc + (size_t)((rs >> 6) * 2 + (i - 62)) * DFF; }
                }
#pragma unroll
                for (int bj = 0; bj < 2; ++bj) {
                    const f32x4 v0 = acc[ai][bj][m][0], v1 = acc[ai][bj][m][1];
                    *(u32x4*)(dst + (size_t)row * DFF + colt + bj * HALF) = pack8(v0, v1);
                    if (o) { *(f32x4*)(o + colt + bj * HALF) = v0; *(f32x4*)(o + colt + bj * HALF + 4) = v1; }
                }
                asm volatile("" ::: "memory");
            }
    }
};
template <class Epi, class Sched, bool ALIGN_EPI = false, bool SP2 = false>
__device__ __forceinline__ void gemm_phase(PG8_LAS unsigned char* lds, const Gemm g, const Sched& S, const Epi& E) {
    int tid_ = threadIdx.x; asm volatile("" : "+v"(tid_));
    const int tid = tid_, wid = __builtin_amdgcn_readfirstlane(tid >> 6), lane = tid & 63, wr = wid >> 2, wc = wid & 3, fr = lane & 15, fq = lane >> 4;
    const int K = g.K, nt = K / BK;
    unsigned voffA[2], voffB[2];
#pragma unroll
    for (int i = 0; i < 2; ++i) { int R, C; stage_rc(tid * 16 + i * 8192, R, C); const int Rb = Epi::PERM ? ((R & ~31) + perm32(R & 31)) : R;
        voffA[i] = (unsigned)(R * K + C) * 2u; voffB[i] = (unsigned)(Rb * K + C) * 2u; }
    const size_t kstep = (size_t)(BK * 2);
    const size_t hstep = (size_t)HALF * K * 2;
    const size_t tstep = 2 * hstep;
    const unsigned ldsw = (unsigned)wid * 1024u;
    const int aoff = lds_byte(wr * 64 + fr, fq * 8), boff = lds_byte(wc * 32 + fr, fq * 8);
#define PG8_SA(b, h) (((b) * 2 + (h)) * HTB)
#define PG8_SB(b, h) ((4 + (b) * 2 + (h)) * HTB)
#define PG8_STAGE(bufoff, gbase, voff) do { _Pragma("unroll") for (int _i = 0; _i < 2; ++_i) \
        __builtin_amdgcn_global_load_lds((const unsigned*)((const char*)(gbase) + (voff)[_i]), (PG8_LAS unsigned*)(lds + (bufoff) + ldsw + _i * 8192), 16, 0, 0); } while (0)
#define PG8_LDA(dst, b, h) do { _Pragma("unroll") for (int m = 0; m < 4; ++m) _Pragma("unroll") for (int k = 0; k < 2; ++k) dst[m][k] = *(const PG8_LAS bf16x8*)(lds + PG8_SA(b, h) + aoff + m * 2048 + k * 1024); } while (0)
#define PG8_LDB(dst, b, h) do { _Pragma("unroll") for (int n = 0; n < 2; ++n) _Pragma("unroll") for (int k = 0; k < 2; ++k) dst[n][k] = *(const PG8_LAS bf16x8*)(lds + PG8_SB(b, h) + boff + n * 2048 + k * 1024); } while (0)
#define PG8_MMA(ai, bj, At, Bt) do { __builtin_amdgcn_s_setprio(1); _Pragma("unroll") for (int m = 0; m < 4; ++m) _Pragma("unroll") for (int n = 0; n < 2; ++n) _Pragma("unroll") for (int k = 0; k < 2; ++k) \
        acc[ai][bj][m][n] = __builtin_amdgcn_mfma_f32_16x16x32_bf16(Bt[n][k], At[m][k], acc[ai][bj][m][n], 0, 0, 0); __builtin_amdgcn_s_setprio(0); } while (0)
#define PG8_WAIT_V(n) asm volatile("s_waitcnt vmcnt(" #n ")" ::: "memory")
#define PG8_WAIT_L(n) asm volatile("s_waitcnt lgkmcnt(" #n ")" ::: "memory")
#define PG8_BAR __builtin_amdgcn_s_barrier()
#define PG8_SCHED __builtin_amdgcn_sched_barrier(0)
    Unit cur, nxt; int ui = 0;
    if (!S.next(0, cur)) return;
    f32x4 acc[2][2][4][2];
#pragma unroll
    for (int a = 0; a < 2; ++a)
#pragma unroll
        for (int b = 0; b < 2; ++b)
#pragma unroll
            for (int m = 0; m < 4; ++m)
#pragma unroll
                for (int n = 0; n < 2; ++n) acc[a][b][m][n] = (f32x4){0.f, 0.f, 0.f, 0.f};
    bf16x8 At[4][2], B0[2][2], B1[2][2];
    const char* cA = (const char*)g.A + (size_t)cur.pm * tstep; const char* cB = (const char*)g.Bt + (size_t)cur.pn * tstep;
    S.a_ready(cur);
    if constexpr (SP2) {
        PG8_STAGE(PG8_SB(0, 0), cB, voffB); PG8_STAGE(PG8_SB(0, 1), cB + hstep, voffB); PG8_STAGE(PG8_SA(0, 0), cA, voffA); PG8_STAGE(PG8_SA(0, 1), cA + hstep, voffA);
        if (wr == 1) PG8_BAR;
        PG8_WAIT_V(2); PG8_BAR;
        PG8_STAGE(PG8_SB(1, 0), cB + kstep, voffB); PG8_STAGE(PG8_SA(1, 0), cA + kstep, voffA); PG8_STAGE(PG8_SB(1, 1), cB + hstep + kstep, voffB);
        PG8_WAIT_V(6); PG8_BAR;
    } else {
        PG8_STAGE(PG8_SB(0, 0), cB, voffB); PG8_STAGE(PG8_SA(0, 0), cA, voffA); PG8_STAGE(PG8_SB(0, 1), cB + hstep, voffB); PG8_STAGE(PG8_SA(0, 1), cA + hstep, voffA);
        if (wr == 1) PG8_BAR;
        PG8_WAIT_V(4); PG8_BAR;
        PG8_STAGE(PG8_SB(1, 0), cB + kstep, voffB); PG8_STAGE(PG8_SA(1, 0), cA + kstep, voffA); PG8_STAGE(PG8_SB(1, 1), cB + hstep + kstep, voffB);
        PG8_WAIT_V(6); PG8_BAR;
    }
    for (;;) {
        const bool has_next = S.next(ui + 1, nxt);
        const char* nA = has_next ? (const char*)g.A + (size_t)nxt.pm * tstep : cA; const char* nB = has_next ? (const char*)g.Bt + (size_t)nxt.pn * tstep : cB;
        for (int t = 0; t < nt; t += 2) {
            const bool last = (t == nt - 2);
            const char* a1 = cA + (size_t)(t + 1) * kstep;
            const char* a2 = last ? nA : cA + (size_t)(t + 2) * kstep; const char* b2 = last ? nB : cB + (size_t)(t + 2) * kstep;
            const char* a3 = a2 + kstep; const char* b3 = b2 + kstep;
            if (last && has_next) S.a_ready(nxt);
            if constexpr (SP2) {
            PG8_LDB(B0, 0, 0); PG8_LDB(B1, 0, 1); PG8_SCHED; PG8_LDA(At, 0, 0); PG8_STAGE(PG8_SA(1, 1), a1 + hstep, voffA);
            PG8_WAIT_V(8); PG8_WAIT_L(0); PG8_BAR; PG8_MMA(0, 0, At, B0); PG8_MMA(0, 1, At, B1); PG8_BAR; PG8_SCHED;
            PG8_LDA(At, 0, 1); PG8_STAGE(PG8_SB(0, 0), b2, voffB); PG8_STAGE(PG8_SB(0, 1), b2 + hstep, voffB); PG8_STAGE(PG8_SA(0, 0), a2, voffA);
            PG8_WAIT_V(8); PG8_WAIT_L(0); PG8_BAR; PG8_MMA(1, 0, At, B0); PG8_MMA(1, 1, At, B1); PG8_BAR; PG8_SCHED;
            PG8_LDB(B0, 1, 0); PG8_LDB(B1, 1, 1); PG8_SCHED; PG8_LDA(At, 1, 0); PG8_STAGE(PG8_SA(0, 1), a2 + hstep, voffA);
            PG8_WAIT_V(8); PG8_WAIT_L(0); PG8_BAR; PG8_MMA(0, 0, At, B0); PG8_MMA(0, 1, At, B1); PG8_BAR; PG8_SCHED;
            PG8_LDA(At, 1, 1); PG8_STAGE(PG8_SB(1, 0), b3, voffB); PG8_STAGE(PG8_SB(1, 1), b3 + hstep, voffB); PG8_STAGE(PG8_SA(1, 0), a3, voffA);
            PG8_WAIT_V(8); PG8_WAIT_L(0); PG8_BAR; PG8_MMA(1, 0, At, B0); PG8_MMA(1, 1, At, B1); PG8_BAR; PG8_SCHED;
            } else {
            PG8_LDB(B0, 0, 0); PG8_SCHED; PG8_LDA(At, 0, 0); PG8_STAGE(PG8_SA(1, 1), a1 + hstep, voffA);
            PG8_WAIT_L(8); PG8_BAR; PG8_WAIT_L(0); PG8_MMA(0, 0, At, B0); PG8_BAR; PG8_SCHED;
            PG8_LDB(B1, 0, 1); PG8_STAGE(PG8_SB(0, 0), b2, voffB);
            PG8_BAR; PG8_WAIT_L(0); PG8_MMA(0, 1, At, B1); PG8_BAR;
            PG8_LDA(At, 0, 1); PG8_STAGE(PG8_SA(0, 0), a2, voffA);
            PG8_BAR; PG8_WAIT_L(0); PG8_MMA(1, 0, At, B0); PG8_BAR; PG8_SCHED;
            PG8_STAGE(PG8_SB(0, 1), b2 + hstep, voffB);
            PG8_WAIT_V(6); PG8_BAR; PG8_MMA(1, 1, At, B1); PG8_BAR;
            PG8_LDB(B0, 1, 0); PG8_SCHED; PG8_LDA(At, 1, 0); PG8_STAGE(PG8_SA(0, 1), a2 + hstep, voffA);
            PG8_WAIT_L(8); PG8_BAR; PG8_WAIT_L(0); PG8_MMA(0, 0, At, B0); PG8_BAR; PG8_SCHED;
            PG8_LDB(B1, 1, 1); PG8_STAGE(PG8_SB(1, 0), b3, voffB);
            PG8_BAR; PG8_WAIT_L(0); PG8_MMA(0, 1, At, B1); PG8_BAR;
            PG8_LDA(At, 1, 1); PG8_STAGE(PG8_SA(1, 0), a3, voffA);
            PG8_BAR; PG8_WAIT_L(0); PG8_MMA(1, 0, At, B0); PG8_BAR; PG8_SCHED;
            PG8_STAGE(PG8_SB(1, 1), b3 + hstep, voffB);
            PG8_WAIT_V(6); PG8_BAR; PG8_MMA(1, 1, At, B1); PG8_BAR;
            }
        }
        if constexpr (ALIGN_EPI) { if (wr == 0) PG8_BAR; }
        if constexpr (!Epi::AFTER_DRAIN) { E(acc, cur, wr, wc, fr, fq); S.done(cur); }
        if (!has_next) break;
#pragma unroll
        for (int a = 0; a < 2; ++a)
#pragma unroll
            for (int b = 0; b < 2; ++b)
#pragma unroll
                for (int m = 0; m < 4; ++m)
#pragma unroll
                    for (int n = 0; n < 2; ++n) acc[a][b][m][n] = (f32x4){0.f, 0.f, 0.f, 0.f};
        cur = nxt; cA = nA; cB = nB; ++ui;
        if constexpr (ALIGN_EPI) { if (wr == 1) PG8_BAR; }
    }
    PG8_WAIT_V(0);
    if constexpr (!ALIGN_EPI) { if (wr == 0) PG8_BAR; }
    PG8_BAR;
    if constexpr (Epi::AFTER_DRAIN) { E.fused(acc, cur, wr, wc, fr, fq, lds, wid, lane); S.done(cur); }
#undef PG8_SA
#undef PG8_SB
#undef PG8_STAGE
#undef PG8_LDA
#undef PG8_LDB
#undef PG8_MMA
#undef PG8_WAIT_V
#undef PG8_WAIT_L
#undef PG8_BAR
#undef PG8_SCHED
}
}
#define LAS __attribute__((address_space(3)))
using pg8::bf16_t; using pg8::bf16x8; using pg8::f32x4; using pg8::u32x4; using pg8::cvt_pk_bf16;
using pg8::MP; using pg8::MS; using pg8::MT; using pg8::DMODEL; using pg8::DIN; using pg8::DFF; using pg8::SEQ;
typedef float f32x16 __attribute__((ext_vector_type(16)));
typedef unsigned u32x2 __attribute__((ext_vector_type(2)));
constexpr int NWAVES = 8, NTHR = 512;
constexpr int LDS_BYTES = 147456;
constexpr float EPS = 1e-6f, LOG2E = 1.4426950408889634f;
constexpr size_t MiB = 1u << 20;
constexpr size_t WS_WIN = 1 * MiB, WS_WOUT = 8 * MiB, WS_WUG = 12 * MiB, WS_WDN = 34 * MiB, WS_WSB = 45 * MiB, WS_H = 46 * MiB, WS_R2 = 111 * MiB;
constexpr size_t SZ_Q = (size_t)MT * 512 * 2, SZ_KV = (size_t)MT * 128 * 2, SZ_AM = (size_t)MT * 1024 * 2, SZ_FF = (size_t)MT * DFF * 2;
constexpr size_t WS_Q = WS_R2, WS_K = WS_Q + SZ_Q, WS_V = WS_K + SZ_KV, WS_U = WS_V + SZ_KV, WS_GV = WS_U + SZ_Q, WS_AM = WS_GV + SZ_Q;
constexpr size_t WS_AU = WS_R2, WS_GG = WS_AU + SZ_FF, WS_END = WS_GG + SZ_FF;
static_assert(WS_AM + SZ_AM <= WS_END && WS_END <= 512 * MiB, "ws map");
constexpr size_t O_YP = 0, O_YS = 33554432, O_PK = 34078720, O_PV = 34209792, O_PC = 34340864, O_SK = 34385920, O_SV = 34648064, O_SC = 34910208, O_SG = 35000320;

struct Params { const float* in[21]; float* out; unsigned char* ws; int ph_lo, ph_hi; };
enum { I_XP = 0, I_XS, I_CK, I_CV, I_CC, I_N1G, I_WIN, I_SINK, I_VG, I_WS, I_GB, I_AOG, I_GOG, I_WOUT, I_N2G, I_WUP, I_WGATE, I_CW, I_CB, I_WDN, I_FG };

__device__ __forceinline__ float wave_sum(float v) {
#pragma unroll
    for (int o = 1; o < 64; o <<= 1) v += __shfl_xor(v, o);
    return v;
}
__device__ __forceinline__ float bf2f(unsigned short b) { return __uint_as_float((unsigned)b << 16); }
__device__ __forceinline__ int crow(int r, int hi) { return (r & 3) + 8 * (r >> 2) + 4 * hi; }
#define LDS_WAIT() asm volatile("s_waitcnt lgkmcnt(0)" ::: "memory")

__device__ __forceinline__ void p0_transpose_item(const float* W, int K, int N, bf16_t* WT, int row_off, LAS float* scr, int item, int lane) {
    const int nblk = N / 32, kb = item / nblk, nb = item % nblk, k0 = 64 * kb, n0 = 32 * nb;
#pragma unroll 8
    for (int i = 0; i < 32; ++i) { const int kk = 2 * i + (lane >> 5); scr[kk * 33 + (lane & 31)] = W[(size_t)(k0 + kk) * N + n0 + (lane & 31)]; }
    LDS_WAIT();
    const int c = lane & 7;
#pragma unroll
    for (int j = 0; j < 4; ++j) { const int n = (lane >> 3) + 8 * j; const LAS float* s = scr + (8 * c) * 33 + n;
        u32x4 o; o.x = cvt_pk_bf16(s[0 * 33], s[1 * 33]); o.y = cvt_pk_bf16(s[2 * 33], s[3 * 33]); o.z = cvt_pk_bf16(s[4 * 33], s[5 * 33]); o.w = cvt_pk_bf16(s[6 * 33], s[7 * 33]);
        *(u32x4*)(WT + (size_t)(row_off + n0 + n) * K + k0 + 8 * c) = o; }
    LDS_WAIT();
}
__device__ __forceinline__ void p0_prologue(const Params& P, LAS unsigned char* lds, int G) {
    int tid_ = threadIdx.x; asm volatile("" : "+v"(tid_)); const int tid = tid_, lane = tid & 63, wave = tid >> 6;
    LAS float* scr = (LAS float*)(lds + wave * 16384);
    const int gw = blockIdx.x * NWAVES + wave, NGW = G * NWAVES;
    constexpr int I_IN = 16 * (DIN / 32), I_OUT = 16 * 32, I_UP = 16 * (DFF / 32), I_DN = (DFF / 64) * 32, I_L = I_IN + I_OUT + 2 * I_UP + I_DN;
    for (int it = gw; it < 2 * I_L; it += NGW) {
        const int l = it / I_L; int r = it % I_L;
        bf16_t* win = (bf16_t*)(P.ws + WS_WIN) + (size_t)l * DIN * 1024; bf16_t* wout = (bf16_t*)(P.ws + WS_WOUT) + (size_t)l * 1024 * 1024;
        bf16_t* wug = (bf16_t*)(P.ws + WS_WUG) + (size_t)l * 2 * DFF * 1024; bf16_t* wdn = (bf16_t*)(P.ws + WS_WDN) + (size_t)l * 1024 * DFF;
        if (r < I_IN) { p0_transpose_item(P.in[I_WIN] + (size_t)l * 1024 * DIN, 1024, DIN, win, 0, scr, r, lane); continue; } r -= I_IN;
        if (r < I_OUT) { p0_transpose_item(P.in[I_WOUT] + (size_t)l * 1024 * 1024, 1024, 1024, wout, 0, scr, r, lane); continue; } r -= I_OUT;
        if (r < I_UP) { p0_transpose_item(P.in[I_WUP] + (size_t)l * 1024 * DFF, 1024, DFF, wug, 0, scr, r, lane); continue; } r -= I_UP;
        if (r < I_UP) { p0_transpose_item(P.in[I_WGATE] + (size_t)l * 1024 * DFF, 1024, DFF, wug, DFF, scr, r, lane); continue; } r -= I_UP;
        p0_transpose_item(P.in[I_WDN] + (size_t)l * DFF * 1024, DFF, 1024, wdn, 0, scr, r, lane);
    }
    const int gt = blockIdx.x * NTHR + tid, NGT = G * NTHR;
    bf16_t* wsb = (bf16_t*)(P.ws + WS_WSB);
    for (int i = gt; i < 2 * 8 * 128 * 128 / 4; i += NGT) { const f32x4 v = *(const f32x4*)(P.in[I_WS] + (size_t)i * 4); u32x2 o; o.x = cvt_pk_bf16(v[0], v[1]); o.y = cvt_pk_bf16(v[2], v[3]); *(u32x2*)(wsb + (size_t)i * 4) = o; }
    for (int i = gt; i < 2 * 8 * 64 * 128 / 4; i += NGT) { const int e = i * 4, c = e & 127, r = (e >> 7) & 63, lb = e >> 13; const size_t src = ((size_t)lb * 128 + 64 + r) * 128 + c, dst = ((size_t)lb * 128 + r) * 128 + c;
        *(f32x4*)(P.out + O_SK + dst) = *(const f32x4*)(P.in[I_CK] + src); *(f32x4*)(P.out + O_SV + dst) = *(const f32x4*)(P.in[I_CV] + src); }
}
template <bool TO_BF16> __device__ __forceinline__ void norm_rows(const float* xp, const float* xs, const float* g, bf16_t* H, float* O, int G) {
    int tid_ = threadIdx.x; asm volatile("" : "+v"(tid_)); const int tid = tid_, lane = tid & 63, wave = tid >> 6; const int gw = blockIdx.x * NWAVES + wave, NGW = G * NWAVES;
    f32x4 gv[4];
#pragma unroll
    for (int j = 0; j < 4; ++j) gv[j] = *(const f32x4*)(g + 4 * lane + 256 * j);
    for (int m = gw; m < MT; m += NGW) {
        const float* xr = (m < MP) ? xp + (size_t)m * DMODEL : xs + (size_t)(m - MP) * DMODEL;
        f32x4 v[4]; float s = 0.f;
#pragma unroll
        for (int j = 0; j < 4; ++j) { v[j] = *(const f32x4*)(xr + 4 * lane + 256 * j); s += (v[j][0] * v[j][0] + v[j][1] * v[j][1]) + (v[j][2] * v[j][2] + v[j][3] * v[j][3]); }
        const float rstd = __builtin_amdgcn_rsqf(wave_sum(s) * (1.f / DMODEL) + EPS);
#pragma unroll
        for (int j = 0; j < 4; ++j) { const f32x4 y = v[j] * rstd * gv[j];
            if (TO_BF16) { u32x2 o; o.x = cvt_pk_bf16(y[0], y[1]); o.y = cvt_pk_bf16(y[2], y[3]); *(u32x2*)(H + (size_t)m * DMODEL + 4 * lane + 256 * j) = o; }
            else *(f32x4*)(O + (size_t)m * DMODEL + 4 * lane + 256 * j) = y; }
    }
}
__device__ __forceinline__ void store_t(bf16_t* AM, size_t row, int col0, int hi, const f32x16 (&o)[2], float rstd, const float* gain) {
#pragma unroll
    for (int db = 0; db < 2; ++db)
#pragma unroll
        for (int rq = 0; rq < 4; ++rq) { const int c = col0 + 32 * db + 8 * rq + 4 * hi; const f32x4 gg = *(const f32x4*)(gain + c);
            u32x2 w; w.x = cvt_pk_bf16(o[db][4 * rq] * rstd * gg[0], o[db][4 * rq + 1] * rstd * gg[1]); w.y = cvt_pk_bf16(o[db][4 * rq + 2] * rstd * gg[2], o[db][4 * rq + 3] * rstd * gg[3]);
            *(u32x2*)(AM + row * 1024 + c) = w; }
}
constexpr int KS_STRIDE = 144, VT_STRIDE = 400;
constexpr int AT_KS = 0, AT_VT = 2 * 192 * KS_STRIDE, AT_SS = AT_VT + 2 * 64 * VT_STRIDE;
__device__ __forceinline__ void attn_item(const Params& P, LAS unsigned char* lds, int l, bool smp, int b, int c) {
    int tid_ = threadIdx.x; asm volatile("" : "+v"(tid_)); const int tid = tid_, lane = tid & 63, h = __builtin_amdgcn_readfirstlane(tid >> 6), r32 = lane & 31, hi = lane >> 5;
    const bf16_t* Q = (const bf16_t*)(P.ws + WS_Q); const bf16_t* Kb = (const bf16_t*)(P.ws + WS_K); const bf16_t* Vb = (const bf16_t*)(P.ws + WS_V); bf16_t* AM = (bf16_t*)(P.ws + WS_AM);
    const size_t rowbase = smp ? (size_t)MP + b * 64 : (size_t)b * SEQ + c * 64;
#pragma unroll 2
    for (int it = 0; it < 6; ++it) {
        const int idx = tid + it * NTHR, key = idx >> 4, ch = idx & 15, kvh = ch >> 3, d0 = (ch & 7) * 8;
        u32x4 kk = (u32x4){0u, 0u, 0u, 0u}, vv = kk;
        if (smp && key < 128) {
            const size_t src = (((size_t)(l * 8 + b) * 128 + key) * 2 + kvh) * 64 + d0;
            const f32x4 a0 = *(const f32x4*)(P.in[I_CK] + src), a1 = *(const f32x4*)(P.in[I_CK] + src + 4), b0 = *(const f32x4*)(P.in[I_CV] + src), b1 = *(const f32x4*)(P.in[I_CV] + src + 4);
            kk = pg8::pack8(a0, a1); vv = pg8::pack8(b0, b1);
        } else {
            long row = -1;
            if (smp) row = (long)MP + b * 64 + (key - 128); else { const int tok = (c - 2) * 64 + key; if (tok >= 0) row = (long)b * SEQ + tok; }
            if (row >= 0) { kk = *(const u32x4*)(Kb + row * 128 + ch * 8); vv = *(const u32x4*)(Vb + row * 128 + ch * 8); }
        }
        *(LAS u32x4*)(lds + AT_KS + (kvh * 192 + key) * KS_STRIDE + d0 * 2) = kk;
        LAS unsigned short* vt = (LAS unsigned short*)(lds + AT_VT + (kvh * 64 + d0) * VT_STRIDE + key * 2);
#pragma unroll
        for (int e = 0; e < 4; ++e) { const unsigned w = vv[e]; vt[(2 * e) * (VT_STRIDE / 2)] = (unsigned short)(w & 0xffffu); vt[(2 * e + 1) * (VT_STRIDE / 2)] = (unsigned short)(w >> 16); }
    }
    __syncthreads();
    const int kvh = h >> 2;
    const float slope = __builtin_amdgcn_exp2f(-(float)(h + 1)), sink = P.in[I_SINK][l * 8 + h];
    const float* ga = P.in[I_AOG] + l * 512;
#pragma unroll 1
    for (int qb = 0; qb < 2; ++qb) {
        bf16x8 qf[4];
        const bf16_t* qp = Q + (rowbase + 32 * qb + r32) * 512 + h * 64 + hi * 8;
#pragma unroll
        for (int ds = 0; ds < 4; ++ds) qf[ds] = *(const bf16x8*)(qp + ds * 16);
        f32x16 s[6];
#pragma unroll
        for (int kb = 0; kb < 6; ++kb) {
            s[kb] = (f32x16){};
#pragma unroll
            for (int ds = 0; ds < 4; ++ds) { const bf16x8 kf = *(const LAS bf16x8*)(lds + AT_KS + (kvh * 192 + 32 * kb + r32) * KS_STRIDE + (ds * 16 + hi * 8) * 2);
                s[kb] = __builtin_amdgcn_mfma_f32_32x32x16_bf16(kf, qf[ds], s[kb], 0, 0, 0); }
            asm volatile("" ::: "memory");
        }
        const int iq = 32 * qb + r32; const int jmin = smp ? 0 : (2 - c) * 64;
        float mx = -3.0e38f;
#pragma unroll
        for (int kb = 0; kb < 6; ++kb)
#pragma unroll
            for (int r = 0; r < 16; ++r) { const int j = 32 * kb + crow(r, hi); const int dd = 128 + iq - j; const float dist = (float)(dd < 0 ? -dd : dd);
                float v = s[kb][r] * 0.125f - slope * dist; if (j < jmin) v = -1.0e30f; s[kb][r] = v; mx = fmaxf(mx, v); }
        mx = fmaxf(mx, __shfl_xor(mx, 32)); mx = fmaxf(mx, sink);
        float sum = 0.f;
#pragma unroll
        for (int kb = 0; kb < 6; ++kb)
#pragma unroll
            for (int r = 0; r < 16; ++r) { const float e = __builtin_amdgcn_exp2f((s[kb][r] - mx) * LOG2E); s[kb][r] = e; sum += e; }
        sum += __shfl_xor(sum, 32);
        const float inv = 1.0f / (sum + __builtin_amdgcn_exp2f((sink - mx) * LOG2E));
        f32x16 oacc[2]; oacc[0] = (f32x16){}; oacc[1] = (f32x16){};
#pragma unroll
        for (int kb = 0; kb < 6; ++kb)
#pragma unroll
            for (int sl = 0; sl < 2; ++sl) {
                u32x4 pw; pw.x = cvt_pk_bf16(s[kb][8 * sl + 0], s[kb][8 * sl + 1]); pw.y = cvt_pk_bf16(s[kb][8 * sl + 2], s[kb][8 * sl + 3]); pw.z = cvt_pk_bf16(s[kb][8 * sl + 4], s[kb][8 * sl + 5]); pw.w = cvt_pk_bf16(s[kb][8 * sl + 6], s[kb][8 * sl + 7]);
                const bf16x8 pf = __builtin_bit_cast(bf16x8, pw);
#pragma unroll
                for (int db = 0; db < 2; ++db) {
                    const LAS unsigned char* vp = lds + AT_VT + (kvh * 64 + 32 * db + r32) * VT_STRIDE + (32 * kb + 16 * sl + 4 * hi) * 2;
                    const u32x2 lo = *(const LAS u32x2*)vp, hh = *(const LAS u32x2*)(vp + 16);
                    const bf16x8 vf = __builtin_bit_cast(bf16x8, (u32x4){lo.x, lo.y, hh.x, hh.y});
                    oacc[db] = __builtin_amdgcn_mfma_f32_32x32x16_bf16(vf, pf, oacc[db], 0, 0, 0);
                }
                asm volatile("" ::: "memory");
            }
        float ss = 0.f;
#pragma unroll
        for (int db = 0; db < 2; ++db) { oacc[db] = oacc[db] * inv;
#pragma unroll
            for (int r = 0; r < 16; ++r) ss += oacc[db][r] * oacc[db][r]; }
        ss += __shfl_xor(ss, 32);
        LAS float* SS = (LAS float*)(lds + AT_SS) + qb * 256;
        if (hi == 0) SS[r32 * 8 + h] = ss;
        __syncthreads();
        const LAS f32x4* sp = (const LAS f32x4*)SS + r32 * 2; const f32x4 a = sp[0], bq = sp[1];
        const float tot = (a[0] + a[1]) + (a[2] + a[3]) + (bq[0] + bq[1]) + (bq[2] + bq[3]);
        store_t(AM, rowbase + 32 * qb + r32, h * 64, hi, oacc, __builtin_amdgcn_rsqf(tot * (1.f / 512.f) + EPS), ga);
    }
    __syncthreads();
}
constexpr int GM_VSTRIDE = 272, GM_WAVE = 64 * GM_VSTRIDE, GM_SS = 8 * GM_WAVE;
static_assert(GM_SS + 4096 <= LDS_BYTES && AT_SS + 2048 <= LDS_BYTES, "lds");
__device__ __forceinline__ void gmlp_item(const Params& P, LAS unsigned char* lds, int l, bool smp, int b, int c) {
    int tid_ = threadIdx.x; asm volatile("" : "+v"(tid_)); const int tid = tid_, lane = tid & 63, g = __builtin_amdgcn_readfirstlane(tid >> 6), r32 = lane & 31, hi = lane >> 5;
    const bf16_t* U = (const bf16_t*)(P.ws + WS_U); const bf16_t* GV = (const bf16_t*)(P.ws + WS_GV); bf16_t* AM = (bf16_t*)(P.ws + WS_AM);
    const bf16_t* Wg = (const bf16_t*)(P.ws + WS_WSB) + (size_t)(l * 8 + g) * 128 * 128;
    const size_t rowbase = smp ? (size_t)MP + b * 64 : (size_t)b * SEQ + c * 128;
    const int n = smp ? 64 : 128, nib = n >> 5;
    LAS unsigned char* vt = lds + g * GM_WAVE;
    {
        const int ch = lane & 7; const float* vg = P.in[I_VG] + l * 512 + g * 64 + ch * 8; const f32x4 g0 = *(const f32x4*)vg, g1 = *(const f32x4*)(vg + 4);
        for (int it = 0; it < n / 8; ++it) {
            const int j = it * 8 + (lane >> 3);
            const u32x4 raw = *(const u32x4*)(GV + (rowbase + j) * 512 + g * 64 + ch * 8);
            float x[8];
#pragma unroll
            for (int e = 0; e < 4; ++e) { x[2 * e] = __uint_as_float(raw[e] << 16); x[2 * e + 1] = __uint_as_float(raw[e] & 0xffff0000u); }
            float ss = 0.f;
#pragma unroll
            for (int e = 0; e < 8; ++e) ss += x[e] * x[e];
            ss += __shfl_xor(ss, 1); ss += __shfl_xor(ss, 2); ss += __shfl_xor(ss, 4);
            const float rstd = __builtin_amdgcn_rsqf(ss * (1.f / 64.f) + EPS);
#pragma unroll
            for (int e = 0; e < 4; ++e) { x[e] = x[e] * rstd * g0[e]; x[4 + e] = x[4 + e] * rstd * g1[e]; }
            if (smp) { float* o = P.out + O_SG + ((size_t)(l * 8 + b) * 64 + j) * 512 + g * 64 + ch * 8; *(f32x4*)o = (f32x4){x[0], x[1], x[2], x[3]}; *(f32x4*)(o + 4) = (f32x4){x[4], x[5], x[6], x[7]}; }
            LAS unsigned short* w = (LAS unsigned short*)(vt + (ch * 8) * GM_VSTRIDE + j * 2);
#pragma unroll
            for (int e = 0; e < 4; ++e) { const unsigned pk = cvt_pk_bf16(x[2 * e], x[2 * e + 1]); w[(2 * e) * (GM_VSTRIDE / 2)] = (unsigned short)(pk & 0xffffu); w[(2 * e + 1) * (GM_VSTRIDE / 2)] = (unsigned short)(pk >> 16); }
        }
        LDS_WAIT();
    }
    const float* gb = P.in[I_GB] + (size_t)(l * 8 + g) * 128;
    const float* gm = P.in[I_GOG] + l * 512;
#pragma unroll 1
    for (int ib = 0; ib < nib; ++ib) {
        f32x16 macc[2]; macc[0] = (f32x16){}; macc[1] = (f32x16){};
        const int i = 32 * ib + r32; const int nk = ib < 2 ? 4 : 8;
        const bf16_t* wp = Wg + (size_t)i * 128 + hi * 8;
#pragma unroll 4
        for (int ks = 0; ks < nk; ++ks) {
            const bf16x8 wf = *(const bf16x8*)(wp + ks * 16);
            const bf16x8 v0 = *(const LAS bf16x8*)(vt + r32 * GM_VSTRIDE + (16 * ks + 8 * hi) * 2), v1 = *(const LAS bf16x8*)(vt + (32 + r32) * GM_VSTRIDE + (16 * ks + 8 * hi) * 2);
            macc[0] = __builtin_amdgcn_mfma_f32_32x32x16_bf16(v0, wf, macc[0], 0, 0, 0); macc[1] = __builtin_amdgcn_mfma_f32_32x32x16_bf16(v1, wf, macc[1], 0, 0, 0);
        }
        const float bias = gb[i]; const bf16_t* up = U + (rowbase + i) * 512 + g * 64 + 4 * hi;
        float ss = 0.f;
#pragma unroll
        for (int db = 0; db < 2; ++db)
#pragma unroll
            for (int rq = 0; rq < 4; ++rq) { const u32x2 uu = *(const u32x2*)(up + 32 * db + 8 * rq);
                const float u0 = __uint_as_float(uu.x << 16), u1 = __uint_as_float(uu.x & 0xffff0000u), u2 = __uint_as_float(uu.y << 16), u3 = __uint_as_float(uu.y & 0xffff0000u);
                f32x16& a = macc[db];
                a[4 * rq] = (a[4 * rq] + bias) * u0; a[4 * rq + 1] = (a[4 * rq + 1] + bias) * u1; a[4 * rq + 2] = (a[4 * rq + 2] + bias) * u2; a[4 * rq + 3] = (a[4 * rq + 3] + bias) * u3;
                ss += (a[4 * rq] * a[4 * rq] + a[4 * rq + 1] * a[4 * rq + 1]) + (a[4 * rq + 2] * a[4 * rq + 2] + a[4 * rq + 3] * a[4 * rq + 3]); }
        ss += __shfl_xor(ss, 32);
        LAS float* SS = (LAS float*)(lds + GM_SS) + (ib & 1) * 256;
        if (hi == 0) SS[r32 * 8 + g] = ss;
        __syncthreads();
        const LAS f32x4* sp = (const LAS f32x4*)SS + r32 * 2; const f32x4 a = sp[0], bq = sp[1];
        const float tot = (a[0] + a[1]) + (a[2] + a[3]) + (bq[0] + bq[1]) + (bq[2] + bq[3]);
        store_t(AM + 512, rowbase + i, g * 64, hi, macc, __builtin_amdgcn_rsqf(tot * (1.f / 512.f) + EPS), gm);
    }
    __syncthreads();
}
__device__ __forceinline__ void conv_phase(const Params& P, int l, int G) {
    int tid_ = threadIdx.x; asm volatile("" : "+v"(tid_)); const int tid = tid_, lane = tid & 63, wave = tid >> 6; const int gw = blockIdx.x * NWAVES + wave, NGW = G * NWAVES;
    const bf16_t* AU = (const bf16_t*)(P.ws + WS_AU); bf16_t* GG = (bf16_t*)(P.ws + WS_GG);
    const float* cw = P.in[I_CW] + (size_t)l * 3 * DFF; const float* cb = P.in[I_CB] + (size_t)l * DFF;
    constexpr int NSEG = MT / 64, NCG = 6;
    for (int it = gw; it < NSEG * NCG; it += NGW) {
        const int seg = it / NCG, cgp = it % NCG, chunk = cgp * 64 + lane;
        if (chunk >= DFF / 8) continue;
        const int col = chunk * 8; const size_t r0 = (size_t)seg * 64;
        float w0[8], w1[8], w2[8], bb[8], p2[8], p1[8];
#pragma unroll
        for (int e = 0; e < 8; ++e) { w0[e] = cw[col + e]; w1[e] = cw[DFF + col + e]; w2[e] = cw[2 * DFF + col + e]; bb[e] = cb[col + e]; p2[e] = 0.f; p1[e] = 0.f; }
        if (r0 >= MP) { const int bs = (int)(r0 - MP) >> 6; const float* cc = P.in[I_CC] + ((size_t)(l * 8 + bs) * 2) * DFF + col;
#pragma unroll
            for (int e = 0; e < 8; ++e) { p2[e] = cc[e]; p1[e] = cc[DFF + e]; } }
        else if ((r0 & (SEQ - 1)) != 0) { const u32x4 a2 = *(const u32x4*)(AU + (r0 - 2) * DFF + col), a1 = *(const u32x4*)(AU + (r0 - 1) * DFF + col);
#pragma unroll
            for (int e = 0; e < 4; ++e) { p2[2 * e] = __uint_as_float(a2[e] << 16); p2[2 * e + 1] = __uint_as_float(a2[e] & 0xffff0000u); p1[2 * e] = __uint_as_float(a1[e] << 16); p1[2 * e + 1] = __uint_as_float(a1[e] & 0xffff0000u); } }
#pragma unroll 2
        for (int t = 0; t < 64; ++t) {
            const u32x4 ar = *(const u32x4*)(AU + (r0 + t) * DFF + col), gr = *(const u32x4*)(GG + (r0 + t) * DFF + col);
            float a[8], gg[8], y[8];
#pragma unroll
            for (int e = 0; e < 4; ++e) { a[2 * e] = __uint_as_float(ar[e] << 16); a[2 * e + 1] = __uint_as_float(ar[e] & 0xffff0000u); gg[2 * e] = __uint_as_float(gr[e] << 16); gg[2 * e + 1] = __uint_as_float(gr[e] & 0xffff0000u); }
#pragma unroll
            for (int e = 0; e < 8; ++e) { const float cv = bb[e] + p2[e] * w0[e] + p1[e] * w1[e] + a[e] * w2[e]; y[e] = pg8::gelu_t(cv) * gg[e]; p2[e] = p1[e]; p1[e] = a[e]; }
            u32x4 o; o.x = cvt_pk_bf16(y[0], y[1]); o.y = cvt_pk_bf16(y[2], y[3]); o.z = cvt_pk_bf16(y[4], y[5]); o.w = cvt_pk_bf16(y[6], y[7]);
            *(u32x4*)(GG + (r0 + t) * DFF + col) = o;
        }
    }
}
#ifndef MK_MULTI
#define MK_MULTI 0
#endif
constexpr int PH_PER_LAYER = 8, N_PHASES = 2 + 2 * PH_PER_LAYER;

__global__ void __launch_bounds__(NTHR, 2) mega_fwd(Params P) {
    extern __shared__ __attribute__((aligned(16))) unsigned char lds_raw[];
    LAS unsigned char* lds = (LAS unsigned char*)lds_raw;
    const int G = gridDim.x;
    float* X = P.out;
    bf16_t* H = (bf16_t*)(P.ws + WS_H);
#if MK_MULTI
#define SEAM() do {} while (0)
#else
    cg::grid_group grid = cg::this_grid();
#define SEAM() grid.sync()
#endif
#define IN(k) (P.ph_lo <= (k) && (k) < P.ph_hi)
#define END(k) do { if ((k) + 1 < P.ph_hi) SEAM(); } while (0)
    if (IN(0)) { p0_prologue(P, lds, G); END(0); }
#pragma unroll 1
    for (int l = 0; l < 2; ++l) {
        const int pb = 1 + l * PH_PER_LAYER;
        const float* xp = l == 0 ? P.in[I_XP] : X; const float* xs = l == 0 ? P.in[I_XS] : X + (size_t)MP * DMODEL;
        if (IN(pb + 0)) { norm_rows<true>(xp, xs, P.in[I_N1G] + l * 1024, H, nullptr, G); END(pb + 0); }
        if (IN(pb + 1)) {
            pg8::Gemm g{H, (const bf16_t*)(P.ws + WS_WIN) + (size_t)l * DIN * 1024, MT, DIN, 1024}; pg8::StaticOrder S; S.init(MT, DIN, G, (int)blockIdx.x);
            pg8::EpiIn E{(bf16_t*)(P.ws + WS_Q), (bf16_t*)(P.ws + WS_K), (bf16_t*)(P.ws + WS_V), (bf16_t*)(P.ws + WS_U), (bf16_t*)(P.ws + WS_GV),
                         P.out + O_PK + (size_t)l * 4 * 128 * 128, P.out + O_PV + (size_t)l * 4 * 128 * 128, P.out + O_SK + (size_t)l * 8 * 128 * 128, P.out + O_SV + (size_t)l * 8 * 128 * 128};
            pg8::gemm_phase<pg8::EpiIn, pg8::StaticOrder, true, true>(lds, g, S, E);
            END(pb + 1);
        }
        if (IN(pb + 2)) {
            for (int it = blockIdx.x; it < 784; it += G) {
                if (it < 520) { const bool smp = it >= 512; attn_item(P, lds, l, smp, smp ? it - 512 : it >> 7, smp ? 0 : it & 127); }
                else { const bool smp = it >= 776; gmlp_item(P, lds, l, smp, smp ? it - 776 : (it - 520) >> 6, smp ? 0 : (it - 520) & 63); }
            }
            END(pb + 2);
        }
        if (IN(pb + 3)) {
            pg8::Gemm g{(const bf16_t*)(P.ws + WS_AM), (const bf16_t*)(P.ws + WS_WOUT) + (size_t)l * 1024 * 1024, MT, 1024, 1024}; pg8::StaticOrder S; S.init(MT, 1024, G, (int)blockIdx.x);
            pg8::EpiRes E{xp, xs, X};
            pg8::gemm_phase<pg8::EpiRes, pg8::StaticOrder, true, true>(lds, g, S, E);
            END(pb + 3);
        }
        if (IN(pb + 4)) { norm_rows<true>(X, X + (size_t)MP * DMODEL, P.in[I_N2G] + l * 1024, H, nullptr, G); END(pb + 4); }
        if (IN(pb + 5)) {
            pg8::Gemm g{H, (const bf16_t*)(P.ws + WS_WUG) + (size_t)l * 2 * DFF * 1024, MT, 2 * DFF, 1024}; pg8::StaticOrder S; S.init(MT, 2 * DFF, G, (int)blockIdx.x);
            pg8::EpiUG E{(bf16_t*)(P.ws + WS_AU), (bf16_t*)(P.ws + WS_GG), P.out + O_PC + (size_t)l * 4 * 2 * DFF, P.out + O_SC + (size_t)l * 8 * 2 * DFF};
            pg8::gemm_phase<pg8::EpiUG, pg8::StaticOrder, true, true>(lds, g, S, E);
            END(pb + 5);
        }
        if (IN(pb + 6)) { conv_phase(P, l, G); END(pb + 6); }
        if (IN(pb + 7)) {
            pg8::Gemm g{(const bf16_t*)(P.ws + WS_GG), (const bf16_t*)(P.ws + WS_WDN) + (size_t)l * 1024 * DFF, MT, 1024, DFF}; pg8::StaticOrder S; S.init(MT, 1024, G, (int)blockIdx.x);
            pg8::EpiRes E{X, X + (size_t)MP * DMODEL, X};
            pg8::gemm_phase<pg8::EpiRes, pg8::StaticOrder, true, true>(lds, g, S, E);
            END(pb + 7);
        }
    }
    if (IN(N_PHASES - 1)) norm_rows<false>(X, X + (size_t)MP * DMODEL, P.in[I_FG], nullptr, X, G);
#undef IN
#undef END
#undef SEAM
}

extern "C" void kernel_launch(void* const* d_in, const int* in_sizes, int n_in, void* d_out, int out_size, void* d_ws, size_t ws_size, hipStream_t stream) {
    static int grid = 0;
    if (grid == 0) {
        int dev = 0, cus = 0, per_cu = 0;
        if (n_in != 21 || ws_size < WS_END) { fprintf(stderr, "kernel_launch: unexpected n_in %d / ws_size %zu (need %zu)\n", n_in, ws_size, (size_t)WS_END); grid = -1; return; }
        hipGetDevice(&dev); hipDeviceGetAttribute(&cus, hipDeviceAttributeMultiprocessorCount, dev);
        if (hipFuncSetAttribute((const void*)mega_fwd, hipFuncAttributeMaxDynamicSharedMemorySize, LDS_BYTES) != hipSuccess) { fprintf(stderr, "kernel_launch: hipFuncSetAttribute failed\n"); grid = -1; return; }
        if (hipOccupancyMaxActiveBlocksPerMultiprocessor(&per_cu, (const void*)mega_fwd, NTHR, LDS_BYTES) != hipSuccess || per_cu < 1) { fprintf(stderr, "kernel_launch: occupancy query says %d\n", per_cu); per_cu = 1; }
        (void)hipGetLastError();
        grid = cus * per_cu;
        fprintf(stderr, "kernel_launch: grid %d (cus %d x %d)\n", grid, cus, per_cu);
    }
    if (grid < 0) return;
    Params p{};
    for (int i = 0; i < 21; ++i) p.in[i] = (const float*)d_in[i];
    p.out = (float*)d_out; p.ws = (unsigned char*)d_ws;
#if MK_MULTI
    for (int k = 0; k < N_PHASES; ++k) { p.ph_lo = k; p.ph_hi = k + 1; hipLaunchKernelGGL(mega_fwd, dim3(grid), dim3(NTHR), LDS_BYTES, stream, p); }
#else
    p.ph_lo = 0; p.ph_hi = N_PHASES;
    void* args[] = {&p};
    hipError_t e = hipLaunchCooperativeKernel((const void*)mega_fwd, dim3(grid), dim3(NTHR), args, LDS_BYTES, stream);
    if (e != hipSuccess) fprintf(stderr, "kernel_launch: cooperative launch failed: %s (grid %d)\n", hipGetErrorString(e), grid);
#endif
}
```

```cpp
#include <hip/hip_runtime.h>
#include <hip/hip_cooperative_groups.h>
#include <cstdio>
#include <cstdint>
namespace cg = cooperative_groups;
#define MK_MULTI 0
namespace pg8 {
#define PG8_LAS __attribute__((address_space(3)))
typedef unsigned short bf16_t;
typedef short bf16x8 __attribute__((ext_vector_type(8)));
typedef float f32x4 __attribute__((ext_vector_type(4)));
typedef unsigned u32x4 __attribute__((ext_vector_type(4)));
constexpr int BM = 256, BK = 64, HALF = 128, HTB = HALF * BK * 2  , STAGE_BYTES = 8 * HTB, NXCD = 8, WGM = 8;

__host__ __device__ __forceinline__ int lds_byte(int r, int c) { const int st = (r >> 4) * 2 + (c >> 5), rr = r & 15, cc = c & 31, ob = rr * 64 + cc * 2; return st * 1024 + (ob ^ (((ob >> 9) & 1) << 5)); }
__host__ __device__ __forceinline__ void stage_rc(int b, int& R, int& C) { const int st = b / 1024, sb = b % 1024, swz = sb ^ (((sb >> 9) & 1) << 5); R = (st >> 1) * 16 + swz / 64; C = (st & 1) * 32 + (swz % 64) / 2; }
__host__ __device__ __forceinline__ int perm32(int rho) { const int n = rho >> 4, i = rho & 15; return 8 * (i >> 2) + 4 * n + (i & 3); }

struct Unit { int pm, pn; };
struct Gemm { const bf16_t* A; const bf16_t* Bt; int M, N, K; };

struct StaticOrder {
    int nM, nN, nwg, G, c;
    __host__ __device__ void init(int M, int N, int G_, int c_) { nM = M / BM; nN = N / BM; nwg = nM * nN; G = G_; c = c_; }
    __host__ __device__ bool next(int i, Unit& u) const {
        const long L = (long)i * G + c; if (L >= nwg) return false;
        int wgid = (int)L; { const int q = nwg / NXCD, r = nwg % NXCD, xcd = wgid % NXCD, off = wgid / NXCD; wgid = (xcd < r ? xcd * (q + 1) : r * (q + 1) + (xcd - r) * q) + off; }
        const int nig = WGM * nN, gid = wgid / nig, fm = gid * WGM, gsz = (nM - fm) < WGM ? (nM - fm) : WGM;
        u.pm = fm + ((wgid % nig) % gsz); u.pn = (wgid % nig) / gsz; return true;
    }
    __device__ __forceinline__ void a_ready(const Unit&) const {}
    __device__ __forceinline__ void done(const Unit&) const {}
};

__device__ __forceinline__ unsigned cvt_pk_bf16(float lo, float hi) { unsigned r; asm volatile("v_cvt_pk_bf16_f32 %0, %1, %2" : "=v"(r) : "v"(lo), "v"(hi)); return r; }
typedef float f32x2 __attribute__((ext_vector_type(2)));
constexpr int MP = 32768, MS = 512, MT = MP + MS, DMODEL = 1024, DIN = 1792, DFF = 2816, SEQ = 8192, DSEQ = 64;
__device__ __forceinline__ float gelu_t(float x) {
    const float u = x * (1.0f + 0.044715f * x * x);
    const float e = __builtin_amdgcn_exp2f(u * (-2.0f * 0.7978845608f * 1.4426950409f));
    return x * __builtin_amdgcn_rcpf(1.0f + e);
}
__device__ __forceinline__ u32x4 pack8(f32x4 v0, f32x4 v1) { u32x4 w; w.x = cvt_pk_bf16(v0[0], v0[1]); w.y = cvt_pk_bf16(v0[2], v0[3]); w.z = cvt_pk_bf16(v1[0], v1[1]); w.w = cvt_pk_bf16(v1[2], v1[3]); return w; }
__device__ __forceinline__ f32x4 gelu4(f32x4 v) { return (f32x4){gelu_t(v[0]), gelu_t(v[1]), gelu_t(v[2]), gelu_t(v[3])}; }

struct EpiIn {
    static constexpr bool PERM = true, AFTER_DRAIN = false;
    bf16_t *Q, *Kb, *Vb, *U, *GV; float *pk, *pv, *sk, *sv;
    __device__ __forceinline__ void operator()(const f32x4 (&acc)[2][2][4][2], const Unit& u, int wr, int wc, int fr, int fq) const {
        const int row0 = u.pm * BM + wr * 64 + fr, pn = u.pn;
        const int cw = wc * 32 + 8 * fq;
#pragma unroll
        for (int ai = 0; ai < 2; ++ai)
#pragma unroll
            for (int m = 0; m < 4; ++m) {
                const int row = row0 + ai * HALF + m * 16;
#pragma unroll
                for (int bj = 0; bj < 2; ++bj) {
                    f32x4 v0 = acc[ai][bj][m][0], v1 = acc[ai][bj][m][1];
                    if (pn < 2) {
                        *(u32x4*)(Q + (size_t)row * 512 + pn * 256 + bj * HALF + cw) = pack8(v0, v1);
                    } else if (pn == 2) {
                        bf16_t* dst = bj == 0 ? Kb : Vb;
                        *(u32x4*)(dst + (size_t)row * 128 + cw) = pack8(v0, v1);
                        float* o = nullptr;
                        if (row < MP) { const int t = row & (SEQ - 1), b = row >> 13; if (t >= SEQ - 128) o = (bj == 0 ? pk : pv) + ((size_t)(b * 128 + (t - (SEQ - 128))) * 128 + cw); }
                        else { const int rs = row - MP, b = rs >> 6, i = rs & 63; o = (bj == 0 ? sk : sv) + ((size_t)(b * 128 + 64 + i) * 128 + cw); }
                        if (o) { *(f32x4*)o = v0; *(f32x4*)(o + 4) = v1; }
                    } else if (pn < 5) {
                        *(u32x4*)(U + (size_t)row * 512 + (pn - 3) * 256 + bj * HALF + cw) = pack8(gelu4(v0), gelu4(v1));
                    } else {
                        *(u32x4*)(GV + (size_t)row * 512 + (pn - 5) * 256 + bj * HALF + cw) = pack8(gelu4(v0), gelu4(v1));
                    }
                }
                asm volatile("" ::: "memory");
            }
    }
};
struct EpiRes {
    static constexpr bool PERM = false, AFTER_DRAIN = false;
    const float* bp; const float* bs; float* X;
    __device__ __forceinline__ void operator()(const f32x4 (&acc)[2][2][4][2], const Unit& u, int wr, int wc, int fr, int fq) const {
        const int row0 = u.pm * BM + wr * 64 + fr; const int col0 = u.pn * BM + wc * 32 + 4 * fq;
        const float* base = (u.pm * BM < MP) ? bp : bs - (size_t)MP * DMODEL;
#pragma unroll
        for (int ai = 0; ai < 2; ++ai)
#pragma unroll
            for (int m = 0; m < 4; ++m) {
                const size_t off = (size_t)(row0 + ai * HALF + m * 16) * DMODEL + col0;
#pragma unroll
                for (int bj = 0; bj < 2; ++bj)
#pragma unroll
                    for (int n = 0; n < 2; ++n) { const f32x4 b = *(const f32x4*)(base + off + bj * HALF + n * 16); *(f32x4*)(X + off + bj * HALF + n * 16) = b + acc[ai][bj][m][n]; }
                asm volatile("" ::: "memory");
            }
    }
};
struct EpiUG {
    static constexpr bool PERM = true, AFTER_DRAIN = false;
    bf16_t *AU, *GG; float *pc, *sc;
    __device__ __forceinline__ void operator()(const f32x4 (&acc)[2][2][4][2], const Unit& u, int wr, int wc, int fr, int fq) const {
        const int row0 = u.pm * BM + wr * 64 + fr; const bool up = u.pn < 11;
        bf16_t* dst = up ? AU : GG; const int colt = (up ? u.pn : u.pn - 11) * BM + wc * 32 + 8 * fq;
#pragma unroll
        for (int ai = 0; ai < 2; ++ai)
#pragma unroll
            for (int m = 0; m < 4; ++m) {
                const int row = row0 + ai * HALF + m * 16;
                float* o = nullptr;
                if (up) {
                    if (row < MP) { const int t = row & (SEQ - 1); if (t >= SEQ - 2) o = pc + (size_t)((row >> 13) * 2 + (t - (SEQ - 2))) * DFF; }
                    else { const int rs = row - MP, i = rs & 63; if (i >= 62) o = sc + (size_t)((rs >> 6) * 2 + (i - 62)) * DFF; }
                }
#pragma unroll
                for (int bj = 0; bj < 2; ++bj) {
                    const f32x4 v0 = acc[ai][bj][m][0], v1 = acc[ai][bj][m][1];
                    *(u32x4*)(dst + (size_t)row * DFF + colt + bj * HALF) = pack8(v0, v1);
                    if (o) { *(f32x4*)(o + colt + bj * HALF) = v0; *(f32x4*)(o + colt + bj * HALF + 4) = v1; }
                }
                asm volatile("" ::: "memory");
            }
    }
};
template <class Epi, class Sched, bool ALIGN_EPI = false, bool SP2 = false>
__device__ __forceinline__ void gemm_phase(PG8_LAS unsigned char* lds, const Gemm g, const Sched& S, const Epi& E) {
    int tid_ = threadIdx.x; asm volatile("" : "+v"(tid_));
    const int tid = tid_, wid = __builtin_amdgcn_readfirstlane(tid >> 6), lane = tid & 63, wr = wid >> 2, wc = wid & 3, fr = lane & 15, fq = lane >> 4;
    const int K = g.K, nt = K / BK;
    unsigned voffA[2], voffB[2];
#pragma unroll
    for (int i = 0; i < 2; ++i) { int R, C; stage_rc(tid * 16 + i * 8192, R, C); const int Rb = Epi::PERM ? ((R & ~31) + perm32(R & 31)) : R;
        voffA[i] = (unsigned)(R * K + C) * 2u; voffB[i] = (unsigned)(Rb * K + C) * 2u; }
    const size_t kstep = (size_t)(BK * 2);
    const size_t hstep = (size_t)HALF * K * 2;
    const size_t tstep = 2 * hstep;
    const unsigned ldsw = (unsigned)wid * 1024u;
    const int aoff = lds_byte(wr * 64 + fr, fq * 8), boff = lds_byte(wc * 32 + fr, fq * 8);
#define PG8_SA(b, h) (((b) * 2 + (h)) * HTB)
#define PG8_SB(b, h) ((4 + (b) * 2 + (h)) * HTB)
#define PG8_STAGE(bufoff, gbase, voff) do { _Pragma("unroll") for (int _i = 0; _i < 2; ++_i) \
        __builtin_amdgcn_global_load_lds((const unsigned*)((const char*)(gbase) + (voff)[_i]), (PG8_LAS unsigned*)(lds + (bufoff) + ldsw + _i * 8192), 16, 0, 0); } while (0)
#define PG8_LDA(dst, b, h) do { _Pragma("unroll") for (int m = 0; m < 4; ++m) _Pragma("unroll") for (int k = 0; k < 2; ++k) dst[m][k] = *(const PG8_LAS bf16x8*)(lds + PG8_SA(b, h) + aoff + m * 2048 + k * 1024); } while (0)
#define PG8_LDB(dst, b, h) do { _Pragma("unroll") for (int n = 0; n < 2; ++n) _Pragma("unroll") for (int k = 0; k < 2; ++k) dst[n][k] = *(const PG8_LAS bf16x8*)(lds + PG8_SB(b, h) + boff + n * 2048 + k * 1024); } while (0)
#define PG8_MMA(ai, bj, At, Bt) do { __builtin_amdgcn_s_setprio(1); _Pragma("unroll") for (int m = 0; m < 4; ++m) _Pragma("unroll") for (int n = 0; n < 2; ++n) _Pragma("unroll") for (int k = 0; k < 2; ++k) \
        acc[ai][bj][m][n] = __builtin_amdgcn_mfma_f32_16x16x32_bf16(Bt[n][k], At[m][k], acc[ai][bj][m][n], 0, 0, 0); __builtin_amdgcn_s_setprio(0); } while (0)
#define PG8_WAIT_V(n) asm volatile("s_waitcnt vmcnt(" #n ")" ::: "memory")
#define PG8_WAIT_L(n) asm volatile("s_waitcnt lgkmcnt(" #n ")" ::: "memory")
#define PG8_BAR __builtin_amdgcn_s_barrier()
#define PG8_SCHED __builtin_amdgcn_sched_barrier(0)
    Unit cur, nxt; int ui = 0;
    if (!S.next(0, cur)) return;
    f32x4 acc[2][2][4][2];
#pragma unroll
    for (int a = 0; a < 2; ++a)
#pragma unroll
        for (int b = 0; b < 2; ++b)
#pragma unroll
            for (int m = 0; m < 4; ++m)
#pragma unroll
                for (int n = 0; n < 2; ++n) acc[a][b][m][n] = (f32x4){0.f, 0.f, 0.f, 0.f};
    bf16x8 At[4][2], B0[2][2], B1[2][2];
    const char* cA = (const char*)g.A + (size_t)cur.pm * tstep; const char* cB = (const char*)g.Bt + (size_t)cur.pn * tstep;
    S.a_ready(cur);
    if constexpr (SP2) {
        PG8_STAGE(PG8_SB(0, 0), cB, voffB); PG8_STAGE(PG8_SB(0, 1), cB + hstep, voffB); PG8_STAGE(PG8_SA(0, 0), cA, voffA); PG8_STAGE(PG8_SA(0, 1), cA + hstep, voffA);
        if (wr == 1) PG8_BAR;
        PG8_WAIT_V(2); PG8_BAR;
        PG8_STAGE(PG8_SB(1, 0), cB + kstep, voffB); PG8_STAGE(PG8_SA(1, 0), cA + kstep, voffA); PG8_STAGE(PG8_SB(1, 1), cB + hstep + kstep, voffB);
        PG8_WAIT_V(6); PG8_BAR;
    } else {
        PG8_STAGE(PG8_SB(0, 0), cB, voffB); PG8_STAGE(PG8_SA(0, 0), cA, voffA); PG8_STAGE(PG8_SB(0, 1), cB + hstep, voffB); PG8_STAGE(PG8_SA(0, 1), cA + hstep, voffA);
        if (wr == 1) PG8_BAR;
        PG8_WAIT_V(4); PG8_BAR;
        PG8_STAGE(PG8_SB(1, 0), cB + kstep, voffB); PG8_STAGE(PG8_SA(1, 0), cA + kstep, voffA); PG8_STAGE(PG8_SB(1, 1), cB + hstep + kstep, voffB);
        PG8_WAIT_V(6); PG8_BAR;
    }
    for (;;) {
        const bool has_next = S.next(ui + 1, nxt);
        const char* nA = has_next ? (const char*)g.A + (size_t)nxt.pm * tstep : cA; const char* nB = has_next ? (const char*)g.Bt + (size_t)nxt.pn * tstep : cB;
        for (int t = 0; t < nt; t += 2) {
            const bool last = (t == nt - 2);
            const char* a1 = cA + (size_t)(t + 1) * kstep;
            const char* a2 = last ? nA : cA + (size_t)(t + 2) * kstep; const char* b2 = last ? nB : cB + (size_t)(t + 2) * kstep;
            const char* a3 = a2 + kstep; const char* b3 = b2 + kstep;
            if (last && has_next) S.a_ready(nxt);
            if constexpr (SP2) {
            PG8_LDB(B0, 0, 0); PG8_LDB(B1, 0, 1); PG8_SCHED; PG8_LDA(At, 0, 0); PG8_STAGE(PG8_SA(1, 1), a1 + hstep, voffA);
            PG8_WAIT_V(8); PG8_WAIT_L(0); PG8_BAR; PG8_MMA(0, 0, At, B0); PG8_MMA(0, 1, At, B1); PG8_BAR; PG8_SCHED;
            PG8_LDA(At, 0, 1); PG8_STAGE(PG8_SB(0, 0), b2, voffB); PG8_STAGE(PG8_SB(0, 1), b2 + hstep, voffB); PG8_STAGE(PG8_SA(0, 0), a2, voffA);
            PG8_WAIT_V(8); PG8_WAIT_L(0); PG8_BAR; PG8_MMA(1, 0, At, B0); PG8_MMA(1, 1, At, B1); PG8_BAR; PG8_SCHED;
            PG8_LDB(B0, 1, 0); PG8_LDB(B1, 1, 1); PG8_SCHED; PG8_LDA(At, 1, 0); PG8_STAGE(PG8_SA(0, 1), a2 + hstep, voffA);
            PG8_WAIT_V(8); PG8_WAIT_L(0); PG8_BAR; PG8_MMA(0, 0, At, B0); PG8_MMA(0, 1, At, B1); PG8_BAR; PG8_SCHED;
            PG8_LDA(At, 1, 1); PG8_STAGE(PG8_SB(1, 0), b3, voffB); PG8_STAGE(PG8_SB(1, 1), b3 + hstep, voffB); PG8_STAGE(PG8_SA(1, 0), a3, voffA);
            PG8_WAIT_V(8); PG8_WAIT_L(0); PG8_BAR; PG8_MMA(1, 0, At, B0); PG8_MMA(1, 1, At, B1); PG8_BAR; PG8_SCHED;
            } else {
            PG8_LDB(B0, 0, 0); PG8_SCHED; PG8_LDA(At, 0, 0); PG8_STAGE(PG8_SA(1, 1), a1 + hstep, voffA);
            PG8_WAIT_L(8); PG8_BAR; PG8_WAIT_L(0); PG8_MMA(0, 0, At, B0); PG8_BAR; PG8_SCHED;
            PG8_LDB(B1, 0, 1); PG8_STAGE(PG8_SB(0, 0), b2, voffB);
            PG8_BAR; PG8_WAIT_L(0); PG8_MMA(0, 1, At, B1); PG8_BAR;
            PG8_LDA(At, 0, 1); PG8_STAGE(PG8_SA(0, 0), a2, voffA);
            PG8_BAR; PG8_WAIT_L(0); PG8_MMA(1, 0, At, B0); PG8_BAR; PG8_SCHED;
            PG8_STAGE(PG8_SB(0, 1), b2 + hstep, voffB);
            PG8_WAIT_V(6); PG8_BAR; PG8_MMA(1, 1, At, B1); PG8_BAR;
            PG8_LDB(B0, 1, 0); PG8_SCHED; PG8_LDA(At, 1, 0); PG8_STAGE(PG8_SA(0, 1), a2 + hstep, voffA);
            PG8_WAIT_L(8); PG8_BAR; PG8_WAIT_L(0); PG8_MMA(0, 0, At, B0); PG8_BAR; PG8_SCHED;
            PG8_LDB(B1, 1, 1); PG8_STAGE(PG8_SB(1, 0), b3, voffB);
            PG8_BAR; PG8_WAIT_L(0); PG8_MMA(0, 1, At, B1); PG8_BAR;
            PG8_LDA(At, 1, 1); PG8_STAGE(PG8_SA(1, 0), a3, voffA);
            PG8_BAR; PG8_WAIT_L(0); PG8_MMA(1, 0, At, B0); PG8_BAR; PG8_SCHED;
            PG8_STAGE(PG8_SB(1, 1), b3 + hstep, voffB);
            PG8_WAIT_V(6); PG8_BAR; PG8_MMA(1, 1, At, B1); PG8_BAR;
            }
        }
        if constexpr (ALIGN_EPI) { if (wr == 0) PG8_BAR; }
        if constexpr (!Epi::AFTER_DRAIN) { E(acc, cur, wr, wc, fr, fq); S.done(cur); }
        if (!has_next) break;
#pragma unroll
        for (int a = 0; a < 2; ++a)
#pragma unroll
            for (int b = 0; b < 2; ++b)
#pragma unroll
                for (int m = 0; m < 4; ++m)
#pragma unroll
                    for (int n = 0; n < 2; ++n) acc[a][b][m][n] = (f32x4){0.f, 0.f, 0.f, 0.f};
        cur = nxt; cA = nA; cB = nB; ++ui;
        if constexpr (ALIGN_EPI) { if (wr == 1) PG8_BAR; }
    }
    PG8_WAIT_V(0);
    if constexpr (!ALIGN_EPI) { if (wr == 0) PG8_BAR; }
    PG8_BAR;
    if constexpr (Epi::AFTER_DRAIN) { E.fused(acc, cur, wr, wc, fr, fq, lds, wid, lane); S.done(cur); }
#undef PG8_SA
#undef PG8_SB
#undef PG8_STAGE
#undef PG8_LDA
#undef PG8_LDB
#undef PG8_MMA
#undef PG8_WAIT_V
#undef PG8_WAIT_L
#undef PG8_BAR
#undef PG8_SCHED
}
}
#define LAS __attribute__((address_space(3)))
using pg8::bf16_t; using pg8::bf16x8; using pg8::f32x4; using pg8::u32x4; using pg8::cvt_pk_bf16;
using pg8::MP; using pg8::MS; using pg8::MT; using pg8::DMODEL; using pg8::DIN; using pg8::DFF; using pg8::SEQ;
typedef float f32x16 __attribute__((ext_vector_type(16)));
typedef unsigned u32x2 __attribute__((ext_vector_type(2)));
constexpr int NWAVES = 8, NTHR = 512;
constexpr int LDS_BYTES = 147456;
constexpr float EPS = 1e-6f, LOG2E = 1.4426950408889634f;
constexpr size_t MiB = 1u << 20;
constexpr size_t WS_WIN = 1 * MiB, WS_WOUT = 8 * MiB, WS_WUG = 12 * MiB, WS_WDN = 34 * MiB, WS_WSB = 45 * MiB, WS_H = 46 * MiB, WS_R2 = 111 * MiB;
constexpr size_t SZ_Q = (size_t)MT * 512 * 2, SZ_KV = (size_t)MT * 128 * 2, SZ_AM = (size_t)MT * 1024 * 2, SZ_FF = (size_t)MT * DFF * 2;
constexpr size_t WS_Q = WS_R2, WS_K = WS_Q + SZ_Q, WS_V = WS_K + SZ_KV, WS_U = WS_V + SZ_KV, WS_GV = WS_U + SZ_Q, WS_AM = WS_GV + SZ_Q;
constexpr size_t WS_AU = WS_R2, WS_GG = WS_AU + SZ_FF, WS_END = WS_GG + SZ_FF;
static_assert(WS_AM + SZ_AM <= WS_END && WS_END <= 512 * MiB, "ws map");
constexpr size_t O_YP = 0, O_YS = 33554432, O_PK = 34078720, O_PV = 34209792, O_PC = 34340864, O_SK = 34385920, O_SV = 34648064, O_SC = 34910208, O_SG = 35000320;

struct Params { const float* in[21]; float* out; unsigned char* ws; int ph_lo, ph_hi; };
enum { I_XP = 0, I_XS, I_CK, I_CV, I_CC, I_N1G, I_WIN, I_SINK, I_VG, I_WS, I_GB, I_AOG, I_GOG, I_WOUT, I_N2G, I_WUP, I_WGATE, I_CW, I_CB, I_WDN, I_FG };

__device__ __forceinline__ float wave_sum(float v) {
#pragma unroll
    for (int o = 1; o < 64; o <<= 1) v += __shfl_xor(v, o);
    return v;
}
__device__ __forceinline__ float bf2f(unsigned short b) { return __uint_as_float((unsigned)b << 16); }
__device__ __forceinline__ int crow(int r, int hi) { return (r & 3) + 8 * (r >> 2) + 4 * hi; }
#define LDS_WAIT() asm volatile("s_waitcnt lgkmcnt(0)" ::: "memory")
constexpr int CW_BAR = 4096;
constexpr int LDS_BARST = LDS_BYTES - 64;
#define XB_TMO      128
#define XB_XCNT(j)  (256  + 64 * (j))
#define XB_XSUB(j)  (1280 + 64 * (j))
#define XB_XGEN(j)  (2304 + 64 * (j))
#define XB_TOP      3328
#define XB_TOPGEN   3392
#define XCD_BAR_WORDS 3456
#define XB_SPIN_CAP (1u << 18)

__device__ __forceinline__ unsigned xb_ld(unsigned* p)              { return __hip_atomic_load(p, __ATOMIC_RELAXED, __HIP_MEMORY_SCOPE_AGENT); }
__device__ __forceinline__ unsigned xb_add(unsigned* p, unsigned v) { return __hip_atomic_fetch_add(p, v, __ATOMIC_RELAXED, __HIP_MEMORY_SCOPE_AGENT); }
__device__ __forceinline__ unsigned xb_xcc_id() { return (unsigned)__builtin_amdgcn_s_getreg((3 << 11) | 20) & 0xFu; }
#define XB_SPIN(cond, bar) do { unsigned _sp = 0; while (cond) { __builtin_amdgcn_s_sleep(1); \
    if ((++_sp & 255u) == 0u) { if (xb_ld(&(bar)[XB_TMO])) break; if (_sp > XB_SPIN_CAP) { atomicAdd(&(bar)[XB_TMO], 1u); break; } } } } while (0)

struct XcdBarrier {
    unsigned* bar; unsigned x;
    volatile LAS unsigned* st;
};

__device__ __forceinline__ XcdBarrier xcd_barrier_post(unsigned* bar, volatile LAS unsigned* st) {
    XcdBarrier b; b.bar = bar; b.x = xb_xcc_id(); b.st = st;
    if (threadIdx.x == 0) (void)xb_add(&bar[XB_XCNT(b.x)], 1u);
    return b;
}
__device__ __forceinline__ void xcd_barrier_complete(unsigned* bar, unsigned x, unsigned& nloc, unsigned& nx) {
    const unsigned G = gridDim.x * gridDim.y * gridDim.z;
    unsigned sum, cnt, mine, sp = 0u;
    for (;;) {
        sum = 0u; cnt = 0u; mine = 0u;
#pragma unroll
        for (unsigned j = 0; j < 16; ++j) { const unsigned c = xb_ld(&bar[XB_XCNT(j)]); sum += c; cnt += (c > 0u) ? 1u : 0u; mine = (j == x) ? c : mine; }
        if (sum == G) break;
        __builtin_amdgcn_s_sleep(1);
        if ((++sp & 255u) == 0u) { if (xb_ld(&bar[XB_TMO])) break; if (sp > XB_SPIN_CAP) { atomicAdd(&bar[XB_TMO], 1u); break; } }
    }
    nloc = mine > 0u ? mine : 1u; nx = cnt > 0u ? cnt : 1u;
}

__device__ __forceinline__ void xcd_barrier(const XcdBarrier& b) {
    asm volatile("s_waitcnt vmcnt(0)" ::: "memory");
    __syncthreads();
    if (threadIdx.x == 0) {
        unsigned* bar = b.bar;
        __builtin_amdgcn_s_waitcnt(0);
        unsigned nloc = b.st[0], nx = b.st[1];
        if (nloc == 0u) { xcd_barrier_complete(bar, b.x, nloc, nx); b.st[0] = nloc; b.st[1] = nx; }
        const unsigned old = xb_add(&bar[XB_XSUB(b.x)], 1u);
        const unsigned gen = old / nloc;
        if (old + 1u == (gen + 1u) * nloc) {
            __builtin_amdgcn_fence(__ATOMIC_RELEASE, "agent");
            asm volatile("s_waitcnt vmcnt(0)" ::: "memory");
            const unsigned og = xb_add(&bar[XB_TOP], 1u);
            const unsigned tg = og / nx;
            if (og + 1u == (tg + 1u) * nx) xb_add(&bar[XB_TOPGEN], 1u);
            else XB_SPIN(xb_ld(&bar[XB_TOPGEN]) == tg, bar);
            __builtin_amdgcn_fence(__ATOMIC_ACQUIRE, "agent");
            xb_add(&bar[XB_XGEN(b.x)], 1u);
            asm volatile("s_waitcnt vmcnt(0)" ::: "memory");
        } else {
            XB_SPIN(xb_ld(&bar[XB_XGEN(b.x)]) == gen, bar);
            __builtin_amdgcn_fence(__ATOMIC_ACQUIRE, "agent");
            asm volatile("s_waitcnt vmcnt(0)" ::: "memory");
        }
    }
    __syncthreads();
}


__device__ __forceinline__ void p0_transpose_item(const float* W, int K, int N, bf16_t* WT, int row_off, LAS float* scr, int item, int lane) {
    const int nblk = N / 32, kb = item / nblk, nb = item % nblk, k0 = 64 * kb, n0 = 32 * nb;
#pragma unroll 8
    for (int i = 0; i < 32; ++i) { const int kk = 2 * i + (lane >> 5); scr[kk * 33 + (lane & 31)] = W[(size_t)(k0 + kk) * N + n0 + (lane & 31)]; }
    LDS_WAIT();
    const int c = lane & 7;
#pragma unroll
    for (int j = 0; j < 4; ++j) { const int n = (lane >> 3) + 8 * j; const LAS float* s = scr + (8 * c) * 33 + n;
        u32x4 o; o.x = cvt_pk_bf16(s[0 * 33], s[1 * 33]); o.y = cvt_pk_bf16(s[2 * 33], s[3 * 33]); o.z = cvt_pk_bf16(s[4 * 33], s[5 * 33]); o.w = cvt_pk_bf16(s[6 * 33], s[7 * 33]);
        *(u32x4*)(WT + (size_t)(row_off + n0 + n) * K + k0 + 8 * c) = o; }
    LDS_WAIT();
}
__device__ __forceinline__ void p0_prologue(const Params& P, LAS unsigned char* lds, int G) {
    int tid_ = threadIdx.x; asm volatile("" : "+v"(tid_)); const int tid = tid_, lane = tid & 63, wave = tid >> 6;
    LAS float* scr = (LAS float*)(lds + wave * 16384);
    const int gw = blockIdx.x * NWAVES + wave, NGW = G * NWAVES;
    constexpr int I_IN = 16 * (DIN / 32), I_OUT = 16 * 32, I_UP = 16 * (DFF / 32), I_DN = (DFF / 64) * 32, I_L = I_IN + I_OUT + 2 * I_UP + I_DN;
    for (int it = gw; it < 2 * I_L; it += NGW) {
        const int l = it / I_L; int r = it % I_L;
        bf16_t* win = (bf16_t*)(P.ws + WS_WIN) + (size_t)l * DIN * 1024; bf16_t* wout = (bf16_t*)(P.ws + WS_WOUT) + (size_t)l * 1024 * 1024;
        bf16_t* wug = (bf16_t*)(P.ws + WS_WUG) + (size_t)l * 2 * DFF * 1024; bf16_t* wdn = (bf16_t*)(P.ws + WS_WDN) + (size_t)l * 1024 * DFF;
        if (r < I_IN) { p0_transpose_item(P.in[I_WIN] + (size_t)l * 1024 * DIN, 1024, DIN, win, 0, scr, r, lane); continue; } r -= I_IN;
        if (r < I_OUT) { p0_transpose_item(P.in[I_WOUT] + (size_t)l * 1024 * 1024, 1024, 1024, wout, 0, scr, r, lane); continue; } r -= I_OUT;
        if (r < I_UP) { p0_transpose_item(P.in[I_WUP] + (size_t)l * 1024 * DFF, 1024, DFF, wug, 0, scr, r, lane); continue; } r -= I_UP;
        if (r < I_UP) { p0_transpose_item(P.in[I_WGATE] + (size_t)l * 1024 * DFF, 1024, DFF, wug, DFF, scr, r, lane); continue; } r -= I_UP;
        p0_transpose_item(P.in[I_WDN] + (size_t)l * DFF * 1024, DFF, 1024, wdn, 0, scr, r, lane);
    }
    const int gt = blockIdx.x * NTHR + tid, NGT = G * NTHR;
    bf16_t* wsb = (bf16_t*)(P.ws + WS_WSB);
    for (int i = gt; i < 2 * 8 * 128 * 128 / 4; i += NGT) { const f32x4 v = *(const f32x4*)(P.in[I_WS] + (size_t)i * 4); u32x2 o; o.x = cvt_pk_bf16(v[0], v[1]); o.y = cvt_pk_bf16(v[2], v[3]); *(u32x2*)(wsb + (size_t)i * 4) = o; }
    for (int i = gt; i < 2 * 8 * 64 * 128 / 4; i += NGT) { const int e = i * 4, c = e & 127, r = (e >> 7) & 63, lb = e >> 13; const size_t src = ((size_t)lb * 128 + 64 + r) * 128 + c, dst = ((size_t)lb * 128 + r) * 128 + c;
        *(f32x4*)(P.out + O_SK + dst) = *(const f32x4*)(P.in[I_CK] + src); *(f32x4*)(P.out + O_SV + dst) = *(const f32x4*)(P.in[I_CV] + src); }
}
template <bool TO_BF16> __device__ __forceinline__ void norm_rows(const float* xp, const float* xs, const float* g, bf16_t* H, float* O, int G) {
    int tid_ = threadIdx.x; asm volatile("" : "+v"(tid_)); const int tid = tid_, lane = tid & 63, wave = tid >> 6; const int gw = blockIdx.x * NWAVES + wave, NGW = G * NWAVES;
    f32x4 gv[4];
#pragma unroll
    for (int j = 0; j < 4; ++j) gv[j] = *(const f32x4*)(g + 4 * lane + 256 * j);
    for (int m = gw; m < MT; m += NGW) {
        const float* xr = (m < MP) ? xp + (size_t)m * DMODEL : xs + (size_t)(m - MP) * DMODEL;
        f32x4 v[4]; float s = 0.f;
#pragma unroll
        for (int j = 0; j < 4; ++j) { v[j] = *(const f32x4*)(xr + 4 * lane + 256 * j); s += (v[j][0] * v[j][0] + v[j][1] * v[j][1]) + (v[j][2] * v[j][2] + v[j][3] * v[j][3]); }
        const float rstd = __builtin_amdgcn_rsqf(wave_sum(s) * (1.f / DMODEL) + EPS);
#pragma unroll
        for (int j = 0; j < 4; ++j) { const f32x4 y = v[j] * rstd * gv[j];
            if (TO_BF16) { u32x2 o; o.x = cvt_pk_bf16(y[0], y[1]); o.y = cvt_pk_bf16(y[2], y[3]); *(u32x2*)(H + (size_t)m * DMODEL + 4 * lane + 256 * j) = o; }
            else *(f32x4*)(O + (size_t)m * DMODEL + 4 * lane + 256 * j) = y; }
    }
}
__device__ __forceinline__ void store_t(bf16_t* AM, size_t row, int col0, int hi, const f32x16 (&o)[2], float rstd, const float* gain) {
#pragma unroll
    for (int db = 0; db < 2; ++db)
#pragma unroll
        for (int rq = 0; rq < 4; ++rq) { const int c = col0 + 32 * db + 8 * rq + 4 * hi; const f32x4 gg = *(const f32x4*)(gain + c);
            u32x2 w; w.x = cvt_pk_bf16(o[db][4 * rq] * rstd * gg[0], o[db][4 * rq + 1] * rstd * gg[1]); w.y = cvt_pk_bf16(o[db][4 * rq + 2] * rstd * gg[2], o[db][4 * rq + 3] * rstd * gg[3]);
            *(u32x2*)(AM + row * 1024 + c) = w; }
}
constexpr int KS_STRIDE = 144, VT_STRIDE = 400;
constexpr int AT_KS = 0, AT_VT = 2 * 192 * KS_STRIDE, AT_SS = AT_VT + 2 * 64 * VT_STRIDE;
__device__ __forceinline__ void attn_item(const Params& P, LAS unsigned char* lds, int l, bool smp, int b, int c) {
    int tid_ = threadIdx.x; asm volatile("" : "+v"(tid_)); const int tid = tid_, lane = tid & 63, h = __builtin_amdgcn_readfirstlane(tid >> 6), r32 = lane & 31, hi = lane >> 5;
    const bf16_t* Q = (const bf16_t*)(P.ws + WS_Q); const bf16_t* Kb = (const bf16_t*)(P.ws + WS_K); const bf16_t* Vb = (const bf16_t*)(P.ws + WS_V); bf16_t* AM = (bf16_t*)(P.ws + WS_AM);
    const size_t rowbase = smp ? (size_t)MP + b * 64 : (size_t)b * SEQ + c * 64;
#pragma unroll 2
    for (int it = 0; it < 6; ++it) {
        const int idx = tid + it * NTHR, key = idx >> 4, ch = idx & 15, kvh = ch >> 3, d0 = (ch & 7) * 8;
        u32x4 kk = (u32x4){0u, 0u, 0u, 0u}, vv = kk;
        if (smp && key < 128) {
            const size_t src = (((size_t)(l * 8 + b) * 128 + key) * 2 + kvh) * 64 + d0;
            const f32x4 a0 = *(const f32x4*)(P.in[I_CK] + src), a1 = *(const f32x4*)(P.in[I_CK] + src + 4), b0 = *(const f32x4*)(P.in[I_CV] + src), b1 = *(const f32x4*)(P.in[I_CV] + src + 4);
            kk = pg8::pack8(a0, a1); vv = pg8::pack8(b0, b1);
        } else {
            long row = -1;
            if (smp) row = (long)MP + b * 64 + (key - 128); else { const int tok = (c - 2) * 64 + key; if (tok >= 0) row = (long)b * SEQ + tok; }
            if (row >= 0) { kk = *(const u32x4*)(Kb + row * 128 + ch * 8); vv = *(const u32x4*)(Vb + row * 128 + ch * 8); }
        }
        *(LAS u32x4*)(lds + AT_KS + (kvh * 192 + key) * KS_STRIDE + d0 * 2) = kk;
        LAS unsigned short* vt = (LAS unsigned short*)(lds + AT_VT + (kvh * 64 + d0) * VT_STRIDE + key * 2);
#pragma unroll
        for (int e = 0; e < 4; ++e) { const unsigned w = vv[e]; vt[(2 * e) * (VT_STRIDE / 2)] = (unsigned short)(w & 0xffffu); vt[(2 * e + 1) * (VT_STRIDE / 2)] = (unsigned short)(w >> 16); }
    }
    __syncthreads();
    const int kvh = h >> 2;
    const float slope = __builtin_amdgcn_exp2f(-(float)(h + 1)), sink = P.in[I_SINK][l * 8 + h];
    const float* ga = P.in[I_AOG] + l * 512;
#pragma unroll 1
    for (int qb = 0; qb < 2; ++qb) {
        bf16x8 qf[4];
        const bf16_t* qp = Q + (rowbase + 32 * qb + r32) * 512 + h * 64 + hi * 8;
#pragma unroll
        for (int ds = 0; ds < 4; ++ds) qf[ds] = *(const bf16x8*)(qp + ds * 16);
        f32x16 s[6];
#pragma unroll
        for (int kb = 0; kb < 6; ++kb) {
            s[kb] = (f32x16){};
#pragma unroll
            for (int ds = 0; ds < 4; ++ds) { const bf16x8 kf = *(const LAS bf16x8*)(lds + AT_KS + (kvh * 192 + 32 * kb + r32) * KS_STRIDE + (ds * 16 + hi * 8) * 2);
                s[kb] = __builtin_amdgcn_mfma_f32_32x32x16_bf16(kf, qf[ds], s[kb], 0, 0, 0); }
            asm volatile("" ::: "memory");
        }
        const int iq = 32 * qb + r32; const int jmin = smp ? 0 : (2 - c) * 64;
        float mx = -3.0e38f;
#pragma unroll
        for (int kb = 0; kb < 6; ++kb)
#pragma unroll
            for (int r = 0; r < 16; ++r) { const int j = 32 * kb + crow(r, hi); const int dd = 128 + iq - j; const float dist = (float)(dd < 0 ? -dd : dd);
                float v = s[kb][r] * 0.125f - slope * dist; if (j < jmin) v = -1.0e30f; s[kb][r] = v; mx = fmaxf(mx, v); }
        mx = fmaxf(mx, __shfl_xor(mx, 32)); mx = fmaxf(mx, sink);
        float sum = 0.f;
#pragma unroll
        for (int kb = 0; kb < 6; ++kb)
#pragma unroll
            for (int r = 0; r < 16; ++r) { const float e = __builtin_amdgcn_exp2f((s[kb][r] - mx) * LOG2E); s[kb][r] = e; sum += e; }
        sum += __shfl_xor(sum, 32);
        const float inv = 1.0f / (sum + __builtin_amdgcn_exp2f((sink - mx) * LOG2E));
        f32x16 oacc[2]; oacc[0] = (f32x16){}; oacc[1] = (f32x16){};
#pragma unroll
        for (int kb = 0; kb < 6; ++kb)
#pragma unroll
            for (int sl = 0; sl < 2; ++sl) {
                u32x4 pw; pw.x = cvt_pk_bf16(s[kb][8 * sl + 0], s[kb][8 * sl + 1]); pw.y = cvt_pk_bf16(s[kb][8 * sl + 2], s[kb][8 * sl + 3]); pw.z = cvt_pk_bf16(s[kb][8 * sl + 4], s[kb][8 * sl + 5]); pw.w = cvt_pk_bf16(s[kb][8 * sl + 6], s[kb][8 * sl + 7]);
                const bf16x8 pf = __builtin_bit_cast(bf16x8, pw);
#pragma unroll
                for (int db = 0; db < 2; ++db) {
                    const LAS unsigned char* vp = lds + AT_VT + (kvh * 64 + 32 * db + r32) * VT_STRIDE + (32 * kb + 16 * sl + 4 * hi) * 2;
                    const u32x2 lo = *(const LAS u32x2*)vp, hh = *(const LAS u32x2*)(vp + 16);
                    const bf16x8 vf = __builtin_bit_cast(bf16x8, (u32x4){lo.x, lo.y, hh.x, hh.y});
                    oacc[db] = __builtin_amdgcn_mfma_f32_32x32x16_bf16(vf, pf, oacc[db], 0, 0, 0);
                }
                asm volatile("" ::: "memory");
            }
        float ss = 0.f;
#pragma unroll
        for (int db = 0; db < 2; ++db) { oacc[db] = oacc[db] * inv;
#pragma unroll
            for (int r = 0; r < 16; ++r) ss += oacc[db][r] * oacc[db][r]; }
        ss += __shfl_xor(ss, 32);
        LAS float* SS = (LAS float*)(lds + AT_SS) + qb * 256;
        if (hi == 0) SS[r32 * 8 + h] = ss;
        __syncthreads();
        const LAS f32x4* sp = (const LAS f32x4*)SS + r32 * 2; const f32x4 a = sp[0], bq = sp[1];
        const float tot = (a[0] + a[1]) + (a[2] + a[3]) + (bq[0] + bq[1]) + (bq[2] + bq[3]);
        store_t(AM, rowbase + 32 * qb + r32, h * 64, hi, oacc, __builtin_amdgcn_rsqf(tot * (1.f / 512.f) + EPS), ga);
    }
    __syncthreads();
}
constexpr int GM_VSTRIDE = 272, GM_WAVE = 64 * GM_VSTRIDE, GM_SS = 8 * GM_WAVE;
static_assert(GM_SS + 4096 <= LDS_BYTES && AT_SS + 2048 <= LDS_BYTES, "lds");
__device__ __forceinline__ void gmlp_item(const Params& P, LAS unsigned char* lds, int l, bool smp, int b, int c) {
    int tid_ = threadIdx.x; asm volatile("" : "+v"(tid_)); const int tid = tid_, lane = tid & 63, g = __builtin_amdgcn_readfirstlane(tid >> 6), r32 = lane & 31, hi = lane >> 5;
    const bf16_t* U = (const bf16_t*)(P.ws + WS_U); const bf16_t* GV = (const bf16_t*)(P.ws + WS_GV); bf16_t* AM = (bf16_t*)(P.ws + WS_AM);
    const bf16_t* Wg = (const bf16_t*)(P.ws + WS_WSB) + (size_t)(l * 8 + g) * 128 * 128;
    const size_t rowbase = smp ? (size_t)MP + b * 64 : (size_t)b * SEQ + c * 128;
    const int n = smp ? 64 : 128, nib = n >> 5;
    LAS unsigned char* vt = lds + g * GM_WAVE;
    {
        const int ch = lane & 7; const float* vg = P.in[I_VG] + l * 512 + g * 64 + ch * 8; const f32x4 g0 = *(const f32x4*)vg, g1 = *(const f32x4*)(vg + 4);
        for (int it = 0; it < n / 8; ++it) {
            const int j = it * 8 + (lane >> 3);
            const u32x4 raw = *(const u32x4*)(GV + (rowbase + j) * 512 + g * 64 + ch * 8);
            float x[8];
#pragma unroll
            for (int e = 0; e < 4; ++e) { x[2 * e] = __uint_as_float(raw[e] << 16); x[2 * e + 1] = __uint_as_float(raw[e] & 0xffff0000u); }
            float ss = 0.f;
#pragma unroll
            for (int e = 0; e < 8; ++e) ss += x[e] * x[e];
            ss += __shfl_xor(ss, 1); ss += __shfl_xor(ss, 2); ss += __shfl_xor(ss, 4);
            const float rstd = __builtin_amdgcn_rsqf(ss * (1.f / 64.f) + EPS);
#pragma unroll
            for (int e = 0; e < 4; ++e) { x[e] = x[e] * rstd * g0[e]; x[4 + e] = x[4 + e] * rstd * g1[e]; }
            if (smp) { float* o = P.out + O_SG + ((size_t)(l * 8 + b) * 64 + j) * 512 + g * 64 + ch * 8; *(f32x4*)o = (f32x4){x[0], x[1], x[2], x[3]}; *(f32x4*)(o + 4) = (f32x4){x[4], x[5], x[6], x[7]}; }
            LAS unsigned short* w = (LAS unsigned short*)(vt + (ch * 8) * GM_VSTRIDE + j * 2);
#pragma unroll
            for (int e = 0; e < 4; ++e) { const unsigned pk = cvt_pk_bf16(x[2 * e], x[2 * e + 1]); w[(2 * e) * (GM_VSTRIDE / 2)] = (unsigned short)(pk & 0xffffu); w[(2 * e + 1) * (GM_VSTRIDE / 2)] = (unsigned short)(pk >> 16); }
        }
        LDS_WAIT();
    }
    const float* gb = P.in[I_GB] + (size_t)(l * 8 + g) * 128;
    const float* gm = P.in[I_GOG] + l * 512;
#pragma unroll 1
    for (int ib = 0; ib < nib; ++ib) {
        f32x16 macc[2]; macc[0] = (f32x16){}; macc[1] = (f32x16){};
        const int i = 32 * ib + r32; const int nk = ib < 2 ? 4 : 8;
        const bf16_t* wp = Wg + (size_t)i * 128 + hi * 8;
#pragma unroll 4
        for (int ks = 0; ks < nk; ++ks) {
            const bf16x8 wf = *(const bf16x8*)(wp + ks * 16);
            const bf16x8 v0 = *(const LAS bf16x8*)(vt + r32 * GM_VSTRIDE + (16 * ks + 8 * hi) * 2), v1 = *(const LAS bf16x8*)(vt + (32 + r32) * GM_VSTRIDE + (16 * ks + 8 * hi) * 2);
            macc[0] = __builtin_amdgcn_mfma_f32_32x32x16_bf16(v0, wf, macc[0], 0, 0, 0); macc[1] = __builtin_amdgcn_mfma_f32_32x32x16_bf16(v1, wf, macc[1], 0, 0, 0);
        }
        const float bias = gb[i]; const bf16_t* up = U + (rowbase + i) * 512 + g * 64 + 4 * hi;
        float ss = 0.f;
#pragma unroll
        for (int db = 0; db < 2; ++db)
#pragma unroll
            for (int rq = 0; rq < 4; ++rq) { const u32x2 uu = *(const u32x2*)(up + 32 * db + 8 * rq);
                const float u0 = __uint_as_float(uu.x << 16), u1 = __uint_as_float(uu.x & 0xffff0000u), u2 = __uint_as_float(uu.y << 16), u3 = __uint_as_float(uu.y & 0xffff0000u);
                f32x16& a = macc[db];
                a[4 * rq] = (a[4 * rq] + bias) * u0; a[4 * rq + 1] = (a[4 * rq + 1] + bias) * u1; a[4 * rq + 2] = (a[4 * rq + 2] + bias) * u2; a[4 * rq + 3] = (a[4 * rq + 3] + bias) * u3;
                ss += (a[4 * rq] * a[4 * rq] + a[4 * rq + 1] * a[4 * rq + 1]) + (a[4 * rq + 2] * a[4 * rq + 2] + a[4 * rq + 3] * a[4 * rq + 3]); }
        ss += __shfl_xor(ss, 32);
        LAS float* SS = (LAS float*)(lds + GM_SS) + (ib & 1) * 256;
        if (hi == 0) SS[r32 * 8 + g] = ss;
        __syncthreads();
        const LAS f32x4* sp = (const LAS f32x4*)SS + r32 * 2; const f32x4 a = sp[0], bq = sp[1];
        const float tot = (a[0] + a[1]) + (a[2] + a[3]) + (bq[0] + bq[1]) + (bq[2] + bq[3]);
        store_t(AM + 512, rowbase + i, g * 64, hi, macc, __builtin_amdgcn_rsqf(tot * (1.f / 512.f) + EPS), gm);
    }
    __syncthreads();
}
__device__ __forceinline__ void conv_phase(const Params& P, int l, int G) {
    int tid_ = threadIdx.x; asm volatile("" : "+v"(tid_)); const int tid = tid_, lane = tid & 63, wave = tid >> 6; const int gw = blockIdx.x * NWAVES + wave, NGW = G * NWAVES;
    const bf16_t* AU = (const bf16_t*)(P.ws + WS_AU); bf16_t* GG = (bf16_t*)(P.ws + WS_GG);
    const float* cw = P.in[I_CW] + (size_t)l * 3 * DFF; const float* cb = P.in[I_CB] + (size_t)l * DFF;
    constexpr int NSEG = MT / 64, NCG = 6;
    for (int it = gw; it < NSEG * NCG; it += NGW) {
        const int seg = it / NCG, cgp = it % NCG, chunk = cgp * 64 + lane;
        if (chunk >= DFF / 8) continue;
        const int col = chunk * 8; const size_t r0 = (size_t)seg * 64;
        float w0[8], w1[8], w2[8], bb[8], p2[8], p1[8];
#pragma unroll
        for (int e = 0; e < 8; ++e) { w0[e] = cw[col + e]; w1[e] = cw[DFF + col + e]; w2[e] = cw[2 * DFF + col + e]; bb[e] = cb[col + e]; p2[e] = 0.f; p1[e] = 0.f; }
        if (r0 >= MP) { const int bs = (int)(r0 - MP) >> 6; const float* cc = P.in[I_CC] + ((size_t)(l * 8 + bs) * 2) * DFF + col;
#pragma unroll
            for (int e = 0; e < 8; ++e) { p2[e] = cc[e]; p1[e] = cc[DFF + e]; } }
        else if ((r0 & (SEQ - 1)) != 0) { const u32x4 a2 = *(const u32x4*)(AU + (r0 - 2) * DFF + col), a1 = *(const u32x4*)(AU + (r0 - 1) * DFF + col);
#pragma unroll
            for (int e = 0; e < 4; ++e) { p2[2 * e] = __uint_as_float(a2[e] << 16); p2[2 * e + 1] = __uint_as_float(a2[e] & 0xffff0000u); p1[2 * e] = __uint_as_float(a1[e] << 16); p1[2 * e + 1] = __uint_as_float(a1[e] & 0xffff0000u); } }
#pragma unroll 2
        for (int t = 0; t < 64; ++t) {
            const u32x4 ar = *(const u32x4*)(AU + (r0 + t) * DFF + col), gr = *(const u32x4*)(GG + (r0 + t) * DFF + col);
            float a[8], gg[8], y[8];
#pragma unroll
            for (int e = 0; e < 4; ++e) { a[2 * e] = __uint_as_float(ar[e] << 16); a[2 * e + 1] = __uint_as_float(ar[e] & 0xffff0000u); gg[2 * e] = __uint_as_float(gr[e] << 16); gg[2 * e + 1] = __uint_as_float(gr[e] & 0xffff0000u); }
#pragma unroll
            for (int e = 0; e < 8; ++e) { const float cv = bb[e] + p2[e] * w0[e] + p1[e] * w1[e] + a[e] * w2[e]; y[e] = pg8::gelu_t(cv) * gg[e]; p2[e] = p1[e]; p1[e] = a[e]; }
            u32x4 o; o.x = cvt_pk_bf16(y[0], y[1]); o.y = cvt_pk_bf16(y[2], y[3]); o.z = cvt_pk_bf16(y[4], y[5]); o.w = cvt_pk_bf16(y[6], y[7]);
            *(u32x4*)(GG + (r0 + t) * DFF + col) = o;
        }
    }
}
#ifndef MK_MULTI
#define MK_MULTI 0
#endif
constexpr int PH_PER_LAYER = 8, N_PHASES = 2 + 2 * PH_PER_LAYER;

__global__ void __launch_bounds__(NTHR, 2) mega_fwd(Params P) {
    extern __shared__ __attribute__((aligned(16))) unsigned char lds_raw[];
    LAS unsigned char* lds = (LAS unsigned char*)lds_raw;
    const int G = gridDim.x;
    float* X = P.out;
    bf16_t* H = (bf16_t*)(P.ws + WS_H);
#if MK_MULTI
#define SEAM() do {} while (0)
#else
    cg::grid_group grid = cg::this_grid();
    unsigned* barw = (unsigned*)P.ws + CW_BAR;
    volatile LAS unsigned* barst = (volatile LAS unsigned*)(lds + LDS_BARST);
    if (blockIdx.x == 0) for (int i = threadIdx.x; i < XCD_BAR_WORDS; i += NTHR) __hip_atomic_store(barw + i, 0u, __ATOMIC_RELAXED, __HIP_MEMORY_SCOPE_AGENT);
    if (threadIdx.x < 2) barst[threadIdx.x] = 0u;
    __syncthreads();
    XcdBarrier bar; bar.bar = barw; bar.x = 0; bar.st = barst;
    bool bar_ready = false;
#define SEAM() do { if (!bar_ready) { grid.sync(); bar = xcd_barrier_post(barw, barst); bar_ready = true; } else xcd_barrier(bar); } while (0)
#endif
#define IN(k) (P.ph_lo <= (k) && (k) < P.ph_hi)
#define END(k) do { if ((k) + 1 < P.ph_hi) SEAM(); } while (0)
    if (IN(0)) { p0_prologue(P, lds, G); END(0); }
#pragma unroll 1
    for (int l = 0; l < 2; ++l) {
        const int pb = 1 + l * PH_PER_LAYER;
        const float* xp = l == 0 ? P.in[I_XP] : X; const float* xs = l == 0 ? P.in[I_XS] : X + (size_t)MP * DMODEL;
        if (IN(pb + 0)) { norm_rows<true>(xp, xs, P.in[I_N1G] + l * 1024, H, nullptr, G); END(pb + 0); }
        if (IN(pb + 1)) {
            pg8::Gemm g{H, (const bf16_t*)(P.ws + WS_WIN) + (size_t)l * DIN * 1024, MT, DIN, 1024}; pg8::StaticOrder S; S.init(MT, DIN, G, (int)blockIdx.x);
            pg8::EpiIn E{(bf16_t*)(P.ws + WS_Q), (bf16_t*)(P.ws + WS_K), (bf16_t*)(P.ws + WS_V), (bf16_t*)(P.ws + WS_U), (bf16_t*)(P.ws + WS_GV),
                         P.out + O_PK + (size_t)l * 4 * 128 * 128, P.out + O_PV + (size_t)l * 4 * 128 * 128, P.out + O_SK + (size_t)l * 8 * 128 * 128, P.out + O_SV + (size_t)l * 8 * 128 * 128};
            pg8::gemm_phase<pg8::EpiIn, pg8::StaticOrder, true, true>(lds, g, S, E);
            END(pb + 1);
        }
        if (IN(pb + 2)) {
            for (int it = blockIdx.x; it < 784; it += G) {
                if (it < 520) { const bool smp = it >= 512; attn_item(P, lds, l, smp, smp ? it - 512 : it >> 7, smp ? 0 : it & 127); }
                else { const bool smp = it >= 776; gmlp_item(P, lds, l, smp, smp ? it - 776 : (it - 520) >> 6, smp ? 0 : (it - 520) & 63); }
            }
            END(pb + 2);
        }
        if (IN(pb + 3)) {
            pg8::Gemm g{(const bf16_t*)(P.ws + WS_AM), (const bf16_t*)(P.ws + WS_WOUT) + (size_t)l * 1024 * 1024, MT, 1024, 1024}; pg8::StaticOrder S; S.init(MT, 1024, G, (int)blockIdx.x);
            pg8::EpiRes E{xp, xs, X};
            pg8::gemm_phase<pg8::EpiRes, pg8::StaticOrder, true, true>(lds, g, S, E);
            END(pb + 3);
        }
        if (IN(pb + 4)) { norm_rows<true>(X, X + (size_t)MP * DMODEL, P.in[I_N2G] + l * 1024, H, nullptr, G); END(pb + 4); }
        if (IN(pb + 5)) {
            pg8::Gemm g{H, (const bf16_t*)(P.ws + WS_WUG) + (size_t)l * 2 * DFF * 1024, MT, 2 * DFF, 1024}; pg8::StaticOrder S; S.init(MT, 2 * DFF, G, (int)blockIdx.x);
            pg8::EpiUG E{(bf16_t*)(P.ws + WS_AU), (bf16_t*)(P.ws + WS_GG), P.out + O_PC + (size_t)l * 4 * 2 * DFF, P.out + O_SC + (size_t)l * 8 * 2 * DFF};
            pg8::gemm_phase<pg8::EpiUG, pg8::StaticOrder, true, true>(lds, g, S, E);
            END(pb + 5);
        }
        if (IN(pb + 6)) { conv_phase(P, l, G); END(pb + 6); }
        if (IN(pb + 7)) {
            pg8::Gemm g{(const bf16_t*)(P.ws + WS_GG), (const bf16_t*)(P.ws + WS_WDN) + (size_t)l * 1024 * DFF, MT, 1024, DFF}; pg8::StaticOrder S; S.init(MT, 1024, G, (int)blockIdx.x);
            pg8::EpiRes E{X, X + (size_t)MP * DMODEL, X};
            pg8::gemm_phase<pg8::EpiRes, pg8::StaticOrder, true, true>(lds, g, S, E);
            END(pb + 7);
        }
    }
    if (IN(N_PHASES - 1)) norm_rows<false>(X, X + (size_t)MP * DMODEL, P.in[I_FG], nullptr, X, G);
#undef IN
#undef END
#undef SEAM
}

extern "C" void kernel_launch(void* const* d_in, const int* in_sizes, int n_in, void* d_out, int out_size, void* d_ws, size_t ws_size, hipStream_t stream) {
    static int grid = 0;
    if (grid == 0) {
        int dev = 0, cus = 0, per_cu = 0;
        if (n_in != 21 || ws_size < WS_END) { fprintf(stderr, "kernel_launch: unexpected n_in %d / ws_size %zu (need %zu)\n", n_in, ws_size, (size_t)WS_END); grid = -1; return; }
        hipGetDevice(&dev); hipDeviceGetAttribute(&cus, hipDeviceAttributeMultiprocessorCount, dev);
        if (hipFuncSetAttribute((const void*)mega_fwd, hipFuncAttributeMaxDynamicSharedMemorySize, LDS_BYTES) != hipSuccess) { fprintf(stderr, "kernel_launch: hipFuncSetAttribute failed\n"); grid = -1; return; }
        if (hipOccupancyMaxActiveBlocksPerMultiprocessor(&per_cu, (const void*)mega_fwd, NTHR, LDS_BYTES) != hipSuccess || per_cu < 1) { fprintf(stderr, "kernel_launch: occupancy query says %d\n", per_cu); per_cu = 1; }
        (void)hipGetLastError();
        grid = cus * per_cu;
        fprintf(stderr, "kernel_launch: grid %d (cus %d x %d)\n", grid, cus, per_cu);
    }
    if (grid < 0) return;
    Params p{};
    for (int i = 0; i < 21; ++i) p.in[i] = (const float*)d_in[i];
    p.out = (float*)d_out; p.ws = (unsigned char*)d_ws;
#if MK_MULTI
    for (int k = 0; k < N_PHASES; ++k) { p.ph_lo = k; p.ph_hi = k + 1; hipLaunchKernelGGL(mega_fwd, dim3(grid), dim3(NTHR), LDS_BYTES, stream, p); }
#else
    p.ph_lo = 0; p.ph_hi = N_PHASES;
    void* args[] = {&p};
    hipError_t e = hipLaunchCooperativeKernel((const void*)mega_fwd, dim3(grid), dim3(NTHR), args, LDS_BYTES, stream);
    if (e != hipSuccess) fprintf(stderr, "kernel_launch: cooperative launch failed: %s (grid %d)\n", hipGetErrorString(e), grid);
#endif
}
```

```cpp
#include <hip/hip_runtime.h>
#include <hip/hip_cooperative_groups.h>
#include <cstdio>
#include <cstdint>
namespace cg = cooperative_groups;
#define MK_MULTI 0
namespace pg8 {
#define PG8_LAS __attribute__((address_space(3)))
typedef unsigned short bf16_t;
typedef short bf16x8 __attribute__((ext_vector_type(8)));
typedef float f32x4 __attribute__((ext_vector_type(4)));
typedef unsigned u32x4 __attribute__((ext_vector_type(4)));
constexpr int BM = 256, BK = 64, HALF = 128, HTB = HALF * BK * 2  , STAGE_BYTES = 8 * HTB, NXCD = 8, WGM = 8;

__host__ __device__ __forceinline__ int lds_byte(int r, int c) { const int st = (r >> 4) * 2 + (c >> 5), rr = r & 15, cc = c & 31, ob = rr * 64 + cc * 2; return st * 1024 + (ob ^ (((ob >> 9) & 1) << 5)); }
__host__ __device__ __forceinline__ void stage_rc(int b, int& R, int& C) { const int st = b / 1024, sb = b % 1024, swz = sb ^ (((sb >> 9) & 1) << 5); R = (st >> 1) * 16 + swz / 64; C = (st & 1) * 32 + (swz % 64) / 2; }
__host__ __device__ __forceinline__ int perm32(int rho) { const int n = rho >> 4, i = rho & 15; return 8 * (i >> 2) + 4 * n + (i & 3); }

struct Unit { int pm, pn; };
struct Gemm { const bf16_t* A; const bf16_t* Bt; int M, N, K; };

struct StaticOrder {
    int nM, nN, nwg, G, c;
    __host__ __device__ void init(int M, int N, int G_, int c_) { nM = M / BM; nN = N / BM; nwg = nM * nN; G = G_; c = c_; }
    __host__ __device__ bool next(int i, Unit& u) const {
        const long L = (long)i * G + c; if (L >= nwg) return false;
        int wgid = (int)L; { const int q = nwg / NXCD, r = nwg % NXCD, xcd = wgid % NXCD, off = wgid / NXCD; wgid = (xcd < r ? xcd * (q + 1) : r * (q + 1) + (xcd - r) * q) + off; }
        const int nig = WGM * nN, gid = wgid / nig, fm = gid * WGM, gsz = (nM - fm) < WGM ? (nM - fm) : WGM;
        u.pm = fm + ((wgid % nig) % gsz); u.pn = (wgid % nig) / gsz; return true;
    }
    __device__ __forceinline__ void a_ready(const Unit&) const {}
    __device__ __forceinline__ void done(const Unit&) const {}
};

__device__ __forceinline__ unsigned cvt_pk_bf16(float lo, float hi) { unsigned r; asm volatile("v_cvt_pk_bf16_f32 %0, %1, %2" : "=v"(r) : "v"(lo), "v"(hi)); return r; }
typedef float f32x2 __attribute__((ext_vector_type(2)));
constexpr int MP = 32768, MS = 512, MT = MP + MS, DMODEL = 1024, DIN = 1792, DFF = 2816, SEQ = 8192, DSEQ = 64;
__device__ __forceinline__ float gelu_t(float x) {
    const float u = x * (1.0f + 0.044715f * x * x);
    const float e = __builtin_amdgcn_exp2f(u * (-2.0f * 0.7978845608f * 1.4426950409f));
    return x * __builtin_amdgcn_rcpf(1.0f + e);
}
__device__ __forceinline__ u32x4 pack8(f32x4 v0, f32x4 v1) { u32x4 w; w.x = cvt_pk_bf16(v0[0], v0[1]); w.y = cvt_pk_bf16(v0[2], v0[3]); w.z = cvt_pk_bf16(v1[0], v1[1]); w.w = cvt_pk_bf16(v1[2], v1[3]); return w; }
__device__ __forceinline__ f32x4 gelu4(f32x4 v) { return (f32x4){gelu_t(v[0]), gelu_t(v[1]), gelu_t(v[2]), gelu_t(v[3])}; }

struct EpiIn {
    static constexpr bool PERM = true, AFTER_DRAIN = false;
    bf16_t *Q, *Kb, *Vb, *U, *GV; float *pk, *pv, *sk, *sv; const float* ss;
    __device__ __forceinline__ void operator()(const f32x4 (&acc)[2][2][4][2], const Unit& u, int wr, int wc, int fr, int fq) const {
        const int row0 = u.pm * BM + wr * 64 + fr, pn = u.pn;
        const int cw = wc * 32 + 8 * fq;
#pragma unroll
        for (int ai = 0; ai < 2; ++ai)
#pragma unroll
            for (int m = 0; m < 4; ++m) {
                const int row = row0 + ai * HALF + m * 16;
                const float rstd = __builtin_amdgcn_rsqf(ss[row] * (1.f / 1024.f) + 1e-6f);
#pragma unroll
                for (int bj = 0; bj < 2; ++bj) {
                    f32x4 v0 = acc[ai][bj][m][0] * rstd, v1 = acc[ai][bj][m][1] * rstd;
                    if (pn < 2) {
                        *(u32x4*)(Q + (size_t)row * 512 + pn * 256 + bj * HALF + cw) = pack8(v0, v1);
                    } else if (pn == 2) {
                        bf16_t* dst = bj == 0 ? Kb : Vb;
                        *(u32x4*)(dst + (size_t)row * 128 + cw) = pack8(v0, v1);
                        float* o = nullptr;
                        if (row < MP) { const int t = row & (SEQ - 1), b = row >> 13; if (t >= SEQ - 128) o = (bj == 0 ? pk : pv) + ((size_t)(b * 128 + (t - (SEQ - 128))) * 128 + cw); }
                        else { const int rs = row - MP, b = rs >> 6, i = rs & 63; o = (bj == 0 ? sk : sv) + ((size_t)(b * 128 + 64 + i) * 128 + cw); }
                        if (o) { *(f32x4*)o = v0; *(f32x4*)(o + 4) = v1; }
                    } else if (pn < 5) {
                        *(u32x4*)(U + (size_t)row * 512 + (pn - 3) * 256 + bj * HALF + cw) = pack8(gelu4(v0), gelu4(v1));
                    } else {
                        *(u32x4*)(GV + (size_t)row * 512 + (pn - 5) * 256 + bj * HALF + cw) = pack8(gelu4(v0), gelu4(v1));
                    }
                }
                asm volatile("" ::: "memory");
            }
    }
};
struct EpiRes2 {
    static constexpr bool PERM = true, AFTER_DRAIN = false;
    const float* bp; const float* bs; float* X; bf16_t* XB; float* ss;
    __device__ __forceinline__ void operator()(const f32x4 (&acc)[2][2][4][2], const Unit& u, int wr, int wc, int fr, int fq) const {
        const int row0 = u.pm * BM + wr * 64 + fr; const int col0 = u.pn * BM + wc * 32 + 8 * fq;
        const float* base = (u.pm * BM < MP) ? bp : bs - (size_t)MP * DMODEL;
#pragma unroll
        for (int ai = 0; ai < 2; ++ai)
#pragma unroll
            for (int m = 0; m < 4; ++m) {
                const int row = row0 + ai * HALF + m * 16; const size_t off = (size_t)row * DMODEL + col0;
                float s = 0.f;
#pragma unroll
                for (int bj = 0; bj < 2; ++bj) {
                    const f32x4 x0 = *(const f32x4*)(base + off + bj * HALF) + acc[ai][bj][m][0], x1 = *(const f32x4*)(base + off + bj * HALF + 4) + acc[ai][bj][m][1];
                    *(f32x4*)(X + off + bj * HALF) = x0; *(f32x4*)(X + off + bj * HALF + 4) = x1;
                    *(u32x4*)(XB + off + bj * HALF) = pack8(x0, x1);
                    s += ((x0[0] * x0[0] + x0[1] * x0[1]) + (x0[2] * x0[2] + x0[3] * x0[3])) + ((x1[0] * x1[0] + x1[1] * x1[1]) + (x1[2] * x1[2] + x1[3] * x1[3]));
                }
                s += __shfl_xor(s, 16); s += __shfl_xor(s, 32);
                if (fq == 0) (void)__hip_atomic_fetch_add(ss + row, s, __ATOMIC_RELAXED, __HIP_MEMORY_SCOPE_AGENT);
                asm volatile("" ::: "memory");
            }
    }
};
template <int CTRL> __device__ __forceinline__ float dpp_f(float v) { return __int_as_float(__builtin_amdgcn_update_dpp(0, __float_as_int(v), CTRL, 0xf, 0xf, false)); }
template <int CTRL> __device__ __forceinline__ f32x4 dpp4(f32x4 v) { return (f32x4){dpp_f<CTRL>(v[0]), dpp_f<CTRL>(v[1]), dpp_f<CTRL>(v[2]), dpp_f<CTRL>(v[3])}; }
struct EpiUG2 {
    static constexpr bool PERM = true, AFTER_DRAIN = false;
    bf16_t* HM; const float* ss; const float* cw; const float* cb; const float* cc; float *pc, *sc, *AL, *AF, *GF; PG8_LAS unsigned char* halo;
    __device__ __forceinline__ void operator()(f32x4 (&acc)[2][2][4][2], const Unit& u, int wr, int wc, int fr, int fq) const {
        const int row0 = u.pm * BM + wr * 64 + fr; const int cl = wc * 32 + 8 * fq, col = u.pn * HALF + cl;
        const bool smp = u.pm >= MP / BM;
#pragma unroll
        for (int ai = 0; ai < 2; ++ai)
#pragma unroll
            for (int m = 0; m < 4; ++m) { const float rstd = __builtin_amdgcn_rsqf(ss[row0 + ai * HALF + m * 16] * (1.f / 1024.f) + 1e-6f);
                acc[ai][0][m][0] *= rstd; acc[ai][0][m][1] *= rstd; acc[ai][1][m][0] *= rstd; acc[ai][1][m][1] *= rstd; }
        if (fr >= 14) {
#pragma unroll
            for (int ai = 0; ai < 2; ++ai) {
                const f32x4 v0 = acc[ai][0][3][0], v1 = acc[ai][0][3][1];
                PG8_LAS float* hp = (PG8_LAS float*)halo + ((2 * ai + wr) * 2 + (fr - 14)) * HALF + cl; *(PG8_LAS f32x4*)hp = v0; *(PG8_LAS f32x4*)(hp + 4) = v1;
                const int row = row0 + ai * HALF + 48;
                if (smp) { const int rs = row - MP; float* o = sc + (size_t)((rs >> 6) * 2 + (fr - 14)) * DFF + col; *(f32x4*)o = v0; *(f32x4*)(o + 4) = v1; }
                else if (ai == 1 && wr == 1) { float* o = AL + (size_t)(u.pm * 2 + (fr - 14)) * DFF + col; *(f32x4*)o = v0; *(f32x4*)(o + 4) = v1;
                    if ((u.pm & 31) == 31) { float* o2 = pc + (size_t)((u.pm >> 5) * 2 + (fr - 14)) * DFF + col; *(f32x4*)o2 = v0; *(f32x4*)(o2 + 4) = v1; } }
            }
        }
        if (!smp && wr == 0 && fr < 2) { float* o = AF + (size_t)(u.pm * 2 + fr) * DFF + col; *(f32x4*)o = acc[0][0][0][0]; *(f32x4*)(o + 4) = acc[0][0][0][1];
            float* o2 = GF + (size_t)(u.pm * 2 + fr) * DFF + col; *(f32x4*)o2 = acc[0][1][0][0]; *(f32x4*)(o2 + 4) = acc[0][1][0][1]; }
        asm volatile("s_waitcnt lgkmcnt(0)" ::: "memory"); __builtin_amdgcn_s_barrier(); asm volatile("" ::: "memory");
        f32x4 w0[2], w1[2], w2[2], bb[2];
#pragma unroll
        for (int n = 0; n < 2; ++n) { w0[n] = *(const f32x4*)(cw + col + 4 * n); w1[n] = *(const f32x4*)(cw + DFF + col + 4 * n); w2[n] = *(const f32x4*)(cw + 2 * DFF + col + 4 * n); bb[n] = *(const f32x4*)(cb + col + 4 * n); }
#pragma unroll
        for (int ai = 0; ai < 2; ++ai) {
            const int gi = 2 * ai + wr;
            f32x4 t0 = (f32x4){0.f, 0.f, 0.f, 0.f}, t1 = t0;
            if (smp) { const float* cp = cc + (size_t)(((u.pm - MP / BM) * 4 + gi) * 2 + (fr & 1)) * DFF + col; t0 = *(const f32x4*)cp; t1 = *(const f32x4*)(cp + 4); }
            else if (gi > 0) { const PG8_LAS float* hp = (const PG8_LAS float*)halo + ((gi - 1) * 2 + (fr & 1)) * HALF + cl; t0 = *(const PG8_LAS f32x4*)hp; t1 = *(const PG8_LAS f32x4*)(hp + 4); }
            f32x4 x1p[2], x2p[2];
            x1p[0] = dpp4<0x121>(t0); x1p[1] = dpp4<0x121>(t1); x2p[0] = dpp4<0x122>(t0); x2p[1] = dpp4<0x122>(t1);
#pragma unroll
            for (int m = 0; m < 4; ++m) {
                const int row = row0 + ai * HALF + m * 16;
                f32x4 y[2];
#pragma unroll
                for (int n = 0; n < 2; ++n) {
                    const f32x4 a = acc[ai][0][m][n], x1 = dpp4<0x121>(a), x2 = dpp4<0x122>(a);
                    const f32x4 p1 = fr >= 1 ? x1 : x1p[n], p2 = fr >= 2 ? x2 : x2p[n];
                    x1p[n] = x1; x2p[n] = x2;
                    const f32x4 cv = bb[n] + w0[n] * p2 + w1[n] * p1 + w2[n] * a;
                    y[n] = gelu4(cv) * acc[ai][1][m][n];
                }
                *(u32x4*)(HM + (size_t)row * DFF + col) = pack8(y[0], y[1]);
            }
        }
    }
};
template <class Epi, class Sched, bool ALIGN_EPI = false, bool SP2 = false>
__device__ __forceinline__ void gemm_phase(PG8_LAS unsigned char* lds, const Gemm g, const Sched& S, const Epi& E) {
    int tid_ = threadIdx.x; asm volatile("" : "+v"(tid_));
    const int tid = tid_, wid = __builtin_amdgcn_readfirstlane(tid >> 6), lane = tid & 63, wr = wid >> 2, wc = wid & 3, fr = lane & 15, fq = lane >> 4;
    const int K = g.K, nt = K / BK;
    unsigned voffA[2], voffB[2];
#pragma unroll
    for (int i = 0; i < 2; ++i) { int R, C; stage_rc(tid * 16 + i * 8192, R, C); const int Rb = Epi::PERM ? ((R & ~31) + perm32(R & 31)) : R;
        voffA[i] = (unsigned)(R * K + C) * 2u; voffB[i] = (unsigned)(Rb * K + C) * 2u; }
    const size_t kstep = (size_t)(BK * 2);
    const size_t hstep = (size_t)HALF * K * 2;
    const size_t tstep = 2 * hstep;
    const unsigned ldsw = (unsigned)wid * 1024u;
    const int aoff = lds_byte(wr * 64 + fr, fq * 8), boff = lds_byte(wc * 32 + fr, fq * 8);
#define PG8_SA(b, h) (((b) * 2 + (h)) * HTB)
#define PG8_SB(b, h) ((4 + (b) * 2 + (h)) * HTB)
#define PG8_STAGE(bufoff, gbase, voff) do { _Pragma("unroll") for (int _i = 0; _i < 2; ++_i) \
        __builtin_amdgcn_global_load_lds((const unsigned*)((const char*)(gbase) + (voff)[_i]), (PG8_LAS unsigned*)(lds + (bufoff) + ldsw + _i * 8192), 16, 0, 0); } while (0)
#define PG8_LDA(dst, b, h) do { _Pragma("unroll") for (int m = 0; m < 4; ++m) _Pragma("unroll") for (int k = 0; k < 2; ++k) dst[m][k] = *(const PG8_LAS bf16x8*)(lds + PG8_SA(b, h) + aoff + m * 2048 + k * 1024); } while (0)
#define PG8_LDB(dst, b, h) do { _Pragma("unroll") for (int n = 0; n < 2; ++n) _Pragma("unroll") for (int k = 0; k < 2; ++k) dst[n][k] = *(const PG8_LAS bf16x8*)(lds + PG8_SB(b, h) + boff + n * 2048 + k * 1024); } while (0)
#define PG8_MMA(ai, bj, At, Bt) do { __builtin_amdgcn_s_setprio(1); _Pragma("unroll") for (int m = 0; m < 4; ++m) _Pragma("unroll") for (int n = 0; n < 2; ++n) _Pragma("unroll") for (int k = 0; k < 2; ++k) \
        acc[ai][bj][m][n] = __builtin_amdgcn_mfma_f32_16x16x32_bf16(Bt[n][k], At[m][k], acc[ai][bj][m][n], 0, 0, 0); __builtin_amdgcn_s_setprio(0); } while (0)
#define PG8_WAIT_V(n) asm volatile("s_waitcnt vmcnt(" #n ")" ::: "memory")
#define PG8_WAIT_L(n) asm volatile("s_waitcnt lgkmcnt(" #n ")" ::: "memory")
#define PG8_BAR __builtin_amdgcn_s_barrier()
#define PG8_SCHED __builtin_amdgcn_sched_barrier(0)
    Unit cur, nxt; int ui = 0;
    if (!S.next(0, cur)) return;
    f32x4 acc[2][2][4][2];
#pragma unroll
    for (int a = 0; a < 2; ++a)
#pragma unroll
        for (int b = 0; b < 2; ++b)
#pragma unroll
            for (int m = 0; m < 4; ++m)
#pragma unroll
                for (int n = 0; n < 2; ++n) acc[a][b][m][n] = (f32x4){0.f, 0.f, 0.f, 0.f};
    bf16x8 At[4][2], B0[2][2], B1[2][2];
    const char* cA = (const char*)g.A + (size_t)cur.pm * tstep; const char* cB = (const char*)g.Bt + (size_t)cur.pn * tstep;
    S.a_ready(cur);
    if constexpr (SP2) {
        PG8_STAGE(PG8_SB(0, 0), cB, voffB); PG8_STAGE(PG8_SB(0, 1), cB + hstep, voffB); PG8_STAGE(PG8_SA(0, 0), cA, voffA); PG8_STAGE(PG8_SA(0, 1), cA + hstep, voffA);
        if (wr == 1) PG8_BAR;
        PG8_WAIT_V(2); PG8_BAR;
        PG8_STAGE(PG8_SB(1, 0), cB + kstep, voffB); PG8_STAGE(PG8_SA(1, 0), cA + kstep, voffA); PG8_STAGE(PG8_SB(1, 1), cB + hstep + kstep, voffB);
        PG8_WAIT_V(6); PG8_BAR;
    } else {
        PG8_STAGE(PG8_SB(0, 0), cB, voffB); PG8_STAGE(PG8_SA(0, 0), cA, voffA); PG8_STAGE(PG8_SB(0, 1), cB + hstep, voffB); PG8_STAGE(PG8_SA(0, 1), cA + hstep, voffA);
        if (wr == 1) PG8_BAR;
        PG8_WAIT_V(4); PG8_BAR;
        PG8_STAGE(PG8_SB(1, 0), cB + kstep, voffB); PG8_STAGE(PG8_SA(1, 0), cA + kstep, voffA); PG8_STAGE(PG8_SB(1, 1), cB + hstep + kstep, voffB);
        PG8_WAIT_V(6); PG8_BAR;
    }
    for (;;) {
        const bool has_next = S.next(ui + 1, nxt);
        const char* nA = has_next ? (const char*)g.A + (size_t)nxt.pm * tstep : cA; const char* nB = has_next ? (const char*)g.Bt + (size_t)nxt.pn * tstep : cB;
        for (int t = 0; t < nt; t += 2) {
            const bool last = (t == nt - 2);
            const char* a1 = cA + (size_t)(t + 1) * kstep;
            const char* a2 = last ? nA : cA + (size_t)(t + 2) * kstep; const char* b2 = last ? nB : cB + (size_t)(t + 2) * kstep;
            const char* a3 = a2 + kstep; const char* b3 = b2 + kstep;
            if (last && has_next) S.a_ready(nxt);
            if constexpr (SP2) {
            PG8_LDB(B0, 0, 0); PG8_LDB(B1, 0, 1); PG8_SCHED; PG8_LDA(At, 0, 0); PG8_STAGE(PG8_SA(1, 1), a1 + hstep, voffA);
            PG8_WAIT_V(8); PG8_WAIT_L(0); PG8_BAR; PG8_MMA(0, 0, At, B0); PG8_MMA(0, 1, At, B1); PG8_BAR; PG8_SCHED;
            PG8_LDA(At, 0, 1); PG8_STAGE(PG8_SB(0, 0), b2, voffB); PG8_STAGE(PG8_SB(0, 1), b2 + hstep, voffB); PG8_STAGE(PG8_SA(0, 0), a2, voffA);
            PG8_WAIT_V(8); PG8_WAIT_L(0); PG8_BAR; PG8_MMA(1, 0, At, B0); PG8_MMA(1, 1, At, B1); PG8_BAR; PG8_SCHED;
            PG8_LDB(B0, 1, 0); PG8_LDB(B1, 1, 1); PG8_SCHED; PG8_LDA(At, 1, 0); PG8_STAGE(PG8_SA(0, 1), a2 + hstep, voffA);
            PG8_WAIT_V(8); PG8_WAIT_L(0); PG8_BAR; PG8_MMA(0, 0, At, B0); PG8_MMA(0, 1, At, B1); PG8_BAR; PG8_SCHED;
            PG8_LDA(At, 1, 1); PG8_STAGE(PG8_SB(1, 0), b3, voffB); PG8_STAGE(PG8_SB(1, 1), b3 + hstep, voffB); PG8_STAGE(PG8_SA(1, 0), a3, voffA);
            PG8_WAIT_V(8); PG8_WAIT_L(0); PG8_BAR; PG8_MMA(1, 0, At, B0); PG8_MMA(1, 1, At, B1); PG8_BAR; PG8_SCHED;
            } else {
            PG8_LDB(B0, 0, 0); PG8_SCHED; PG8_LDA(At, 0, 0); PG8_STAGE(PG8_SA(1, 1), a1 + hstep, voffA);
            PG8_WAIT_L(8); PG8_BAR; PG8_WAIT_L(0); PG8_MMA(0, 0, At, B0); PG8_BAR; PG8_SCHED;
            PG8_LDB(B1, 0, 1); PG8_STAGE(PG8_SB(0, 0), b2, voffB);
            PG8_BAR; PG8_WAIT_L(0); PG8_MMA(0, 1, At, B1); PG8_BAR;
            PG8_LDA(At, 0, 1); PG8_STAGE(PG8_SA(0, 0), a2, voffA);
            PG8_BAR; PG8_WAIT_L(0); PG8_MMA(1, 0, At, B0); PG8_BAR; PG8_SCHED;
            PG8_STAGE(PG8_SB(0, 1), b2 + hstep, voffB);
            PG8_WAIT_V(6); PG8_BAR; PG8_MMA(1, 1, At, B1); PG8_BAR;
            PG8_LDB(B0, 1, 0); PG8_SCHED; PG8_LDA(At, 1, 0); PG8_STAGE(PG8_SA(0, 1), a2 + hstep, voffA);
            PG8_WAIT_L(8); PG8_BAR; PG8_WAIT_L(0); PG8_MMA(0, 0, At, B0); PG8_BAR; PG8_SCHED;
            PG8_LDB(B1, 1, 1); PG8_STAGE(PG8_SB(1, 0), b3, voffB);
            PG8_BAR; PG8_WAIT_L(0); PG8_MMA(0, 1, At, B1); PG8_BAR;
            PG8_LDA(At, 1, 1); PG8_STAGE(PG8_SA(1, 0), a3, voffA);
            PG8_BAR; PG8_WAIT_L(0); PG8_MMA(1, 0, At, B0); PG8_BAR; PG8_SCHED;
            PG8_STAGE(PG8_SB(1, 1), b3 + hstep, voffB);
            PG8_WAIT_V(6); PG8_BAR; PG8_MMA(1, 1, At, B1); PG8_BAR;
            }
        }
        if constexpr (ALIGN_EPI) { if (wr == 0) PG8_BAR; }
        if constexpr (!Epi::AFTER_DRAIN) { E(acc, cur, wr, wc, fr, fq); S.done(cur); }
        if (!has_next) break;
#pragma unroll
        for (int a = 0; a < 2; ++a)
#pragma unroll
            for (int b = 0; b < 2; ++b)
#pragma unroll
                for (int m = 0; m < 4; ++m)
#pragma unroll
                    for (int n = 0; n < 2; ++n) acc[a][b][m][n] = (f32x4){0.f, 0.f, 0.f, 0.f};
        cur = nxt; cA = nA; cB = nB; ++ui;
        if constexpr (ALIGN_EPI) { if (wr == 1) PG8_BAR; }
    }
    PG8_WAIT_V(0);
    if constexpr (!ALIGN_EPI) { if (wr == 0) PG8_BAR; }
    PG8_BAR;
    if constexpr (Epi::AFTER_DRAIN) { E.fused(acc, cur, wr, wc, fr, fq, lds, wid, lane); S.done(cur); }
#undef PG8_SA
#undef PG8_SB
#undef PG8_STAGE
#undef PG8_LDA
#undef PG8_LDB
#undef PG8_MMA
#undef PG8_WAIT_V
#undef PG8_WAIT_L
#undef PG8_BAR
#undef PG8_SCHED
}
}
#define LAS __attribute__((address_space(3)))
using pg8::bf16_t; using pg8::bf16x8; using pg8::f32x4; using pg8::u32x4; using pg8::cvt_pk_bf16;
using pg8::MP; using pg8::MS; using pg8::MT; using pg8::DMODEL; using pg8::DIN; using pg8::DFF; using pg8::SEQ;
typedef float f32x16 __attribute__((ext_vector_type(16)));
typedef unsigned u32x2 __attribute__((ext_vector_type(2)));
constexpr int NWAVES = 8, NTHR = 512;
constexpr int LDS_BYTES = 147456;
constexpr float EPS = 1e-6f, LOG2E = 1.4426950408889634f;
constexpr size_t MiB = 1u << 20;
constexpr size_t WS_WIN = 1 * MiB, WS_WOUT = 8 * MiB, WS_WUG = 12 * MiB, WS_WDN = 34 * MiB, WS_WSB = 45 * MiB, WS_SS = 46 * MiB, WS_HALO = 47 * MiB, WS_H = 56 * MiB, WS_R2 = 121 * MiB;
constexpr size_t SZ_Q = (size_t)MT * 512 * 2, SZ_KV = (size_t)MT * 128 * 2, SZ_AM = (size_t)MT * 1024 * 2, SZ_FF = (size_t)MT * DFF * 2, SZ_SIDE = (size_t)128 * 2 * DFF * 4;
constexpr size_t WS_Q = WS_R2, WS_K = WS_Q + SZ_Q, WS_V = WS_K + SZ_KV, WS_U = WS_V + SZ_KV, WS_GV = WS_U + SZ_Q, WS_AM = WS_GV + SZ_Q;
constexpr size_t WS_HM = WS_R2, WS_END = WS_AM + SZ_AM;
constexpr size_t WS_AL = WS_HALO, WS_AF = WS_AL + SZ_SIDE, WS_GF = WS_AF + SZ_SIDE;
static_assert(WS_HM + SZ_FF <= WS_END + SZ_FF && WS_END <= 512 * MiB && WS_GF + SZ_SIDE <= WS_H && 5 * (size_t)MT * 4 <= MiB, "ws map");
constexpr size_t O_YP = 0, O_YS = 33554432, O_PK = 34078720, O_PV = 34209792, O_PC = 34340864, O_SK = 34385920, O_SV = 34648064, O_SC = 34910208, O_SG = 35000320;

struct Params { const float* in[21]; float* out; unsigned char* ws; int ph_lo, ph_hi; };
enum { I_XP = 0, I_XS, I_CK, I_CV, I_CC, I_N1G, I_WIN, I_SINK, I_VG, I_WS, I_GB, I_AOG, I_GOG, I_WOUT, I_N2G, I_WUP, I_WGATE, I_CW, I_CB, I_WDN, I_FG };

__device__ __forceinline__ float wave_sum(float v) {
#pragma unroll
    for (int o = 1; o < 64; o <<= 1) v += __shfl_xor(v, o);
    return v;
}
__device__ __forceinline__ float bf2f(unsigned short b) { return __uint_as_float((unsigned)b << 16); }
__device__ __forceinline__ int crow(int r, int hi) { return (r & 3) + 8 * (r >> 2) + 4 * hi; }
#define LDS_WAIT() asm volatile("s_waitcnt lgkmcnt(0)" ::: "memory")
constexpr int CW_BAR = 4096;
constexpr int LDS_BARST = LDS_BYTES - 64;
#define XB_TMO      128
#define XB_XCNT(j)  (256  + 64 * (j))
#define XB_XSUB(j)  (1280 + 64 * (j))
#define XB_XGEN(j)  (2304 + 64 * (j))
#define XB_TOP      3328
#define XB_TOPGEN   3392
#define XCD_BAR_WORDS 3456
#define XB_SPIN_CAP (1u << 18)

__device__ __forceinline__ unsigned xb_ld(unsigned* p)              { return __hip_atomic_load(p, __ATOMIC_RELAXED, __HIP_MEMORY_SCOPE_AGENT); }
__device__ __forceinline__ unsigned xb_add(unsigned* p, unsigned v) { return __hip_atomic_fetch_add(p, v, __ATOMIC_RELAXED, __HIP_MEMORY_SCOPE_AGENT); }
__device__ __forceinline__ unsigned xb_xcc_id() { return (unsigned)__builtin_amdgcn_s_getreg((3 << 11) | 20) & 0xFu; }
#define XB_SPIN(cond, bar) do { unsigned _sp = 0; while (cond) { __builtin_amdgcn_s_sleep(1); \
    if ((++_sp & 255u) == 0u) { if (xb_ld(&(bar)[XB_TMO])) break; if (_sp > XB_SPIN_CAP) { atomicAdd(&(bar)[XB_TMO], 1u); break; } } } } while (0)

struct XcdBarrier {
    unsigned* bar; unsigned x;
    volatile LAS unsigned* st;
};

__device__ __forceinline__ XcdBarrier xcd_barrier_post(unsigned* bar, volatile LAS unsigned* st) {
    XcdBarrier b; b.bar = bar; b.x = xb_xcc_id(); b.st = st;
    if (threadIdx.x == 0) (void)xb_add(&bar[XB_XCNT(b.x)], 1u);
    return b;
}
__device__ __forceinline__ void xcd_barrier_complete(unsigned* bar, unsigned x, unsigned& nloc, unsigned& nx) {
    const unsigned G = gridDim.x * gridDim.y * gridDim.z;
    unsigned sum, cnt, mine, sp = 0u;
    for (;;) {
        sum = 0u; cnt = 0u; mine = 0u;
#pragma unroll
        for (unsigned j = 0; j < 16; ++j) { const unsigned c = xb_ld(&bar[XB_XCNT(j)]); sum += c; cnt += (c > 0u) ? 1u : 0u; mine = (j == x) ? c : mine; }
        if (sum == G) break;
        __builtin_amdgcn_s_sleep(1);
        if ((++sp & 255u) == 0u) { if (xb_ld(&bar[XB_TMO])) break; if (sp > XB_SPIN_CAP) { atomicAdd(&bar[XB_TMO], 1u); break; } }
    }
    nloc = mine > 0u ? mine : 1u; nx = cnt > 0u ? cnt : 1u;
}

__device__ __forceinline__ void xcd_barrier(const XcdBarrier& b) {
    asm volatile("s_waitcnt vmcnt(0)" ::: "memory");
    __syncthreads();
    if (threadIdx.x == 0) {
        unsigned* bar = b.bar;
        __builtin_amdgcn_s_waitcnt(0);
        unsigned nloc = b.st[0], nx = b.st[1];
        if (nloc == 0u) { xcd_barrier_complete(bar, b.x, nloc, nx); b.st[0] = nloc; b.st[1] = nx; }
        const unsigned old = xb_add(&bar[XB_XSUB(b.x)], 1u);
        const unsigned gen = old / nloc;
        if (old + 1u == (gen + 1u) * nloc) {
            __builtin_amdgcn_fence(__ATOMIC_RELEASE, "agent");
            asm volatile("s_waitcnt vmcnt(0)" ::: "memory");
            const unsigned og = xb_add(&bar[XB_TOP], 1u);
            const unsigned tg = og / nx;
            if (og + 1u == (tg + 1u) * nx) xb_add(&bar[XB_TOPGEN], 1u);
            else XB_SPIN(xb_ld(&bar[XB_TOPGEN]) == tg, bar);
            __builtin_amdgcn_fence(__ATOMIC_ACQUIRE, "agent");
            xb_add(&bar[XB_XGEN(b.x)], 1u);
            asm volatile("s_waitcnt vmcnt(0)" ::: "memory");
        } else {
            XB_SPIN(xb_ld(&bar[XB_XGEN(b.x)]) == gen, bar);
            __builtin_amdgcn_fence(__ATOMIC_ACQUIRE, "agent");
            asm volatile("s_waitcnt vmcnt(0)" ::: "memory");
        }
    }
    __syncthreads();
}


__device__ __forceinline__ void p0_transpose_item(const float* W, int K, int N, bf16_t* WT, int dst_row0, LAS float* scr, int kb, int nb, int lane, const float* gk) {
    const int k0 = 64 * kb, n0 = 32 * nb;
#pragma unroll 8
    for (int i = 0; i < 32; ++i) { const int kk = 2 * i + (lane >> 5); const float gs = gk ? gk[k0 + kk] : 1.0f; scr[kk * 33 + (lane & 31)] = W[(size_t)(k0 + kk) * N + n0 + (lane & 31)] * gs; }
    LDS_WAIT();
    const int c = lane & 7;
#pragma unroll
    for (int j = 0; j < 4; ++j) { const int n = (lane >> 3) + 8 * j; const LAS float* s = scr + (8 * c) * 33 + n;
        u32x4 o; o.x = cvt_pk_bf16(s[0 * 33], s[1 * 33]); o.y = cvt_pk_bf16(s[2 * 33], s[3 * 33]); o.z = cvt_pk_bf16(s[4 * 33], s[5 * 33]); o.w = cvt_pk_bf16(s[6 * 33], s[7 * 33]);
        *(u32x4*)(WT + (size_t)(dst_row0 + n) * K + k0 + 8 * c) = o; }
    LDS_WAIT();
}
__device__ __forceinline__ void p0_prologue(const Params& P, LAS unsigned char* lds, int G) {
    int tid_ = threadIdx.x; asm volatile("" : "+v"(tid_)); const int tid = tid_, lane = tid & 63, wave = tid >> 6;
    LAS float* scr = (LAS float*)(lds + wave * 16384);
    const int gw = blockIdx.x * NWAVES + wave, NGW = G * NWAVES;
    constexpr int I_IN = 16 * (DIN / 32), I_OUT = 16 * 32, I_UP = 16 * (DFF / 32), I_DN = (DFF / 64) * 32, I_L = I_IN + I_OUT + 2 * I_UP + I_DN;
    for (int it = gw; it < 2 * I_L; it += NGW) {
        const int l = it / I_L; int r = it % I_L;
        bf16_t* win = (bf16_t*)(P.ws + WS_WIN) + (size_t)l * DIN * 1024; bf16_t* wout = (bf16_t*)(P.ws + WS_WOUT) + (size_t)l * 1024 * 1024;
        bf16_t* wug = (bf16_t*)(P.ws + WS_WUG) + (size_t)l * 2 * DFF * 1024; bf16_t* wdn = (bf16_t*)(P.ws + WS_WDN) + (size_t)l * 1024 * DFF;
        if (r < I_IN) { const int nblk = DIN / 32, kb = r / nblk, nb = r % nblk; p0_transpose_item(P.in[I_WIN] + (size_t)l * 1024 * DIN, 1024, DIN, win, 32 * nb, scr, kb, nb, lane, P.in[I_N1G] + l * 1024); continue; } r -= I_IN;
        if (r < I_OUT) { const int kb = r / 32, nb = r % 32; p0_transpose_item(P.in[I_WOUT] + (size_t)l * 1024 * 1024, 1024, 1024, wout, 32 * nb, scr, kb, nb, lane, nullptr); continue; } r -= I_OUT;
        if (r < 2 * I_UP) { const int gate = r >= I_UP ? 1 : 0; r -= gate * I_UP; const int nblk = DFF / 32, kb = r / nblk, nb = r % nblk, n0 = 32 * nb;
            p0_transpose_item(P.in[gate ? I_WGATE : I_WUP] + (size_t)l * 1024 * DFF, 1024, DFF, wug, 256 * (n0 >> 7) + (n0 & 127) + 128 * gate, scr, kb, nb, lane, P.in[I_N2G] + l * 1024); continue; } r -= 2 * I_UP;
        { const int kb = r / 32, nb = r % 32; p0_transpose_item(P.in[I_WDN] + (size_t)l * DFF * 1024, DFF, 1024, wdn, 32 * nb, scr, kb, nb, lane, nullptr); }
    }
    const int gt = blockIdx.x * NTHR + tid, NGT = G * NTHR;
    bf16_t* wsb = (bf16_t*)(P.ws + WS_WSB);
    for (int i = gt; i < 2 * 8 * 128 * 128 / 4; i += NGT) { const f32x4 v = *(const f32x4*)(P.in[I_WS] + (size_t)i * 4); u32x2 o; o.x = cvt_pk_bf16(v[0], v[1]); o.y = cvt_pk_bf16(v[2], v[3]); *(u32x2*)(wsb + (size_t)i * 4) = o; }
    for (int i = gt; i < 2 * 8 * 64 * 128 / 4; i += NGT) { const int e = i * 4, c = e & 127, r = (e >> 7) & 63, lb = e >> 13; const size_t src = ((size_t)lb * 128 + 64 + r) * 128 + c, dst = ((size_t)lb * 128 + r) * 128 + c;
        *(f32x4*)(P.out + O_SK + dst) = *(const f32x4*)(P.in[I_CK] + src); *(f32x4*)(P.out + O_SV + dst) = *(const f32x4*)(P.in[I_CV] + src); }
    float* ssb = (float*)(P.ws + WS_SS);
    for (int i = gt; i < 4 * MT / 4; i += NGT) *(f32x4*)(ssb + MT + (size_t)i * 4) = (f32x4){0.f, 0.f, 0.f, 0.f};
    bf16_t* XB = (bf16_t*)(P.ws + WS_H);
    for (int m = gw; m < MT; m += NGW) {
        const float* xr = (m < MP) ? P.in[I_XP] + (size_t)m * DMODEL : P.in[I_XS] + (size_t)(m - MP) * DMODEL;
        float sq = 0.f;
#pragma unroll
        for (int j = 0; j < 4; ++j) { const f32x4 v = *(const f32x4*)(xr + 4 * lane + 256 * j); sq += (v[0] * v[0] + v[1] * v[1]) + (v[2] * v[2] + v[3] * v[3]);
            u32x2 o; o.x = cvt_pk_bf16(v[0], v[1]); o.y = cvt_pk_bf16(v[2], v[3]); *(u32x2*)(XB + (size_t)m * DMODEL + 4 * lane + 256 * j) = o; }
        sq = wave_sum(sq); if (lane == 0) ssb[m] = sq;
    }
}
template <bool TO_BF16> __device__ __forceinline__ void norm_rows(const float* xp, const float* xs, const float* g, bf16_t* H, float* O, int G) {
    int tid_ = threadIdx.x; asm volatile("" : "+v"(tid_)); const int tid = tid_, lane = tid & 63, wave = tid >> 6; const int gw = blockIdx.x * NWAVES + wave, NGW = G * NWAVES;
    f32x4 gv[4];
#pragma unroll
    for (int j = 0; j < 4; ++j) gv[j] = *(const f32x4*)(g + 4 * lane + 256 * j);
    for (int m = gw; m < MT; m += NGW) {
        const float* xr = (m < MP) ? xp + (size_t)m * DMODEL : xs + (size_t)(m - MP) * DMODEL;
        f32x4 v[4]; float s = 0.f;
#pragma unroll
        for (int j = 0; j < 4; ++j) { v[j] = *(const f32x4*)(xr + 4 * lane + 256 * j); s += (v[j][0] * v[j][0] + v[j][1] * v[j][1]) + (v[j][2] * v[j][2] + v[j][3] * v[j][3]); }
        const float rstd = __builtin_amdgcn_rsqf(wave_sum(s) * (1.f / DMODEL) + EPS);
#pragma unroll
        for (int j = 0; j < 4; ++j) { const f32x4 y = v[j] * rstd * gv[j];
            if (TO_BF16) { u32x2 o; o.x = cvt_pk_bf16(y[0], y[1]); o.y = cvt_pk_bf16(y[2], y[3]); *(u32x2*)(H + (size_t)m * DMODEL + 4 * lane + 256 * j) = o; }
            else *(f32x4*)(O + (size_t)m * DMODEL + 4 * lane + 256 * j) = y; }
    }
}
__device__ __forceinline__ void store_t(bf16_t* AM, size_t row, int col0, int hi, const f32x16 (&o)[2], float rstd, const float* gain) {
#pragma unroll
    for (int db = 0; db < 2; ++db)
#pragma unroll
        for (int rq = 0; rq < 4; ++rq) { const int c = col0 + 32 * db + 8 * rq + 4 * hi; const f32x4 gg = *(const f32x4*)(gain + c);
            u32x2 w; w.x = cvt_pk_bf16(o[db][4 * rq] * rstd * gg[0], o[db][4 * rq + 1] * rstd * gg[1]); w.y = cvt_pk_bf16(o[db][4 * rq + 2] * rstd * gg[2], o[db][4 * rq + 3] * rstd * gg[3]);
            *(u32x2*)(AM + row * 1024 + c) = w; }
}
constexpr int KS_STRIDE = 144, VT_STRIDE = 400;
constexpr int AT_KS = 0, AT_VT = 2 * 192 * KS_STRIDE, AT_SS = AT_VT + 2 * 64 * VT_STRIDE;
__device__ __forceinline__ void attn_item(const Params& P, LAS unsigned char* lds, int l, bool smp, int b, int c) {
    int tid_ = threadIdx.x; asm volatile("" : "+v"(tid_)); const int tid = tid_, lane = tid & 63, h = __builtin_amdgcn_readfirstlane(tid >> 6), r32 = lane & 31, hi = lane >> 5;
    const bf16_t* Q = (const bf16_t*)(P.ws + WS_Q); const bf16_t* Kb = (const bf16_t*)(P.ws + WS_K); const bf16_t* Vb = (const bf16_t*)(P.ws + WS_V); bf16_t* AM = (bf16_t*)(P.ws + WS_AM);
    const size_t rowbase = smp ? (size_t)MP + b * 64 : (size_t)b * SEQ + c * 64;
#pragma unroll 2
    for (int it = 0; it < 6; ++it) {
        const int idx = tid + it * NTHR, key = idx >> 4, ch = idx & 15, kvh = ch >> 3, d0 = (ch & 7) * 8;
        u32x4 kk = (u32x4){0u, 0u, 0u, 0u}, vv = kk;
        if (smp && key < 128) {
            const size_t src = (((size_t)(l * 8 + b) * 128 + key) * 2 + kvh) * 64 + d0;
            const f32x4 a0 = *(const f32x4*)(P.in[I_CK] + src), a1 = *(const f32x4*)(P.in[I_CK] + src + 4), b0 = *(const f32x4*)(P.in[I_CV] + src), b1 = *(const f32x4*)(P.in[I_CV] + src + 4);
            kk = pg8::pack8(a0, a1); vv = pg8::pack8(b0, b1);
        } else {
            long row = -1;
            if (smp) row = (long)MP + b * 64 + (key - 128); else { const int tok = (c - 2) * 64 + key; if (tok >= 0) row = (long)b * SEQ + tok; }
            if (row >= 0) { kk = *(const u32x4*)(Kb + row * 128 + ch * 8); vv = *(const u32x4*)(Vb + row * 128 + ch * 8); }
        }
        *(LAS u32x4*)(lds + AT_KS + (kvh * 192 + key) * KS_STRIDE + d0 * 2) = kk;
        LAS unsigned short* vt = (LAS unsigned short*)(lds + AT_VT + (kvh * 64 + d0) * VT_STRIDE + key * 2);
#pragma unroll
        for (int e = 0; e < 4; ++e) { const unsigned w = vv[e]; vt[(2 * e) * (VT_STRIDE / 2)] = (unsigned short)(w & 0xffffu); vt[(2 * e + 1) * (VT_STRIDE / 2)] = (unsigned short)(w >> 16); }
    }
    __syncthreads();
    const int kvh = h >> 2;
    const float slope = __builtin_amdgcn_exp2f(-(float)(h + 1)), sink = P.in[I_SINK][l * 8 + h];
    const float* ga = P.in[I_AOG] + l * 512;
#pragma unroll 1
    for (int qb = 0; qb < 2; ++qb) {
        bf16x8 qf[4];
        const bf16_t* qp = Q + (rowbase + 32 * qb + r32) * 512 + h * 64 + hi * 8;
#pragma unroll
        for (int ds = 0; ds < 4; ++ds) qf[ds] = *(const bf16x8*)(qp + ds * 16);
        f32x16 s[6];
#pragma unroll
        for (int kb = 0; kb < 6; ++kb) {
            s[kb] = (f32x16){};
#pragma unroll
            for (int ds = 0; ds < 4; ++ds) { const bf16x8 kf = *(const LAS bf16x8*)(lds + AT_KS + (kvh * 192 + 32 * kb + r32) * KS_STRIDE + (ds * 16 + hi * 8) * 2);
                s[kb] = __builtin_amdgcn_mfma_f32_32x32x16_bf16(kf, qf[ds], s[kb], 0, 0, 0); }
            asm volatile("" ::: "memory");
        }
        const int iq = 32 * qb + r32; const int jmin = smp ? 0 : (2 - c) * 64;
        float mx = -3.0e38f;
#pragma unroll
        for (int kb = 0; kb < 6; ++kb)
#pragma unroll
            for (int r = 0; r < 16; ++r) { const int j = 32 * kb + crow(r, hi); const int dd = 128 + iq - j; const float dist = (float)(dd < 0 ? -dd : dd);
                float v = s[kb][r] * 0.125f - slope * dist; if (j < jmin) v = -1.0e30f; s[kb][r] = v; mx = fmaxf(mx, v); }
        mx = fmaxf(mx, __shfl_xor(mx, 32)); mx = fmaxf(mx, sink);
        float sum = 0.f;
#pragma unroll
        for (int kb = 0; kb < 6; ++kb)
#pragma unroll
            for (int r = 0; r < 16; ++r) { const float e = __builtin_amdgcn_exp2f((s[kb][r] - mx) * LOG2E); s[kb][r] = e; sum += e; }
        sum += __shfl_xor(sum, 32);
        const float inv = 1.0f / (sum + __builtin_amdgcn_exp2f((sink - mx) * LOG2E));
        f32x16 oacc[2]; oacc[0] = (f32x16){}; oacc[1] = (f32x16){};
#pragma unroll
        for (int kb = 0; kb < 6; ++kb)
#pragma unroll
            for (int sl = 0; sl < 2; ++sl) {
                u32x4 pw; pw.x = cvt_pk_bf16(s[kb][8 * sl + 0], s[kb][8 * sl + 1]); pw.y = cvt_pk_bf16(s[kb][8 * sl + 2], s[kb][8 * sl + 3]); pw.z = cvt_pk_bf16(s[kb][8 * sl + 4], s[kb][8 * sl + 5]); pw.w = cvt_pk_bf16(s[kb][8 * sl + 6], s[kb][8 * sl + 7]);
                const bf16x8 pf = __builtin_bit_cast(bf16x8, pw);
#pragma unroll
                for (int db = 0; db < 2; ++db) {
                    const LAS unsigned char* vp = lds + AT_VT + (kvh * 64 + 32 * db + r32) * VT_STRIDE + (32 * kb + 16 * sl + 4 * hi) * 2;
                    const u32x2 lo = *(const LAS u32x2*)vp, hh = *(const LAS u32x2*)(vp + 16);
                    const bf16x8 vf = __builtin_bit_cast(bf16x8, (u32x4){lo.x, lo.y, hh.x, hh.y});
                    oacc[db] = __builtin_amdgcn_mfma_f32_32x32x16_bf16(vf, pf, oacc[db], 0, 0, 0);
                }
                asm volatile("" ::: "memory");
            }
        float ss = 0.f;
#pragma unroll
        for (int db = 0; db < 2; ++db) { oacc[db] = oacc[db] * inv;
#pragma unroll
            for (int r = 0; r < 16; ++r) ss += oacc[db][r] * oacc[db][r]; }
        ss += __shfl_xor(ss, 32);
        LAS float* SS = (LAS float*)(lds + AT_SS) + qb * 256;
        if (hi == 0) SS[r32 * 8 + h] = ss;
        __syncthreads();
        const LAS f32x4* sp = (const LAS f32x4*)SS + r32 * 2; const f32x4 a = sp[0], bq = sp[1];
        const float tot = (a[0] + a[1]) + (a[2] + a[3]) + (bq[0] + bq[1]) + (bq[2] + bq[3]);
        store_t(AM, rowbase + 32 * qb + r32, h * 64, hi, oacc, __builtin_amdgcn_rsqf(tot * (1.f / 512.f) + EPS), ga);
    }
    __syncthreads();
}
constexpr int GM_VSTRIDE = 272, GM_WAVE = 64 * GM_VSTRIDE, GM_SS = 8 * GM_WAVE;
static_assert(GM_SS + 4096 <= LDS_BYTES && AT_SS + 2048 <= LDS_BYTES, "lds");
__device__ __forceinline__ void gmlp_item(const Params& P, LAS unsigned char* lds, int l, bool smp, int b, int c) {
    int tid_ = threadIdx.x; asm volatile("" : "+v"(tid_)); const int tid = tid_, lane = tid & 63, g = __builtin_amdgcn_readfirstlane(tid >> 6), r32 = lane & 31, hi = lane >> 5;
    const bf16_t* U = (const bf16_t*)(P.ws + WS_U); const bf16_t* GV = (const bf16_t*)(P.ws + WS_GV); bf16_t* AM = (bf16_t*)(P.ws + WS_AM);
    const bf16_t* Wg = (const bf16_t*)(P.ws + WS_WSB) + (size_t)(l * 8 + g) * 128 * 128;
    const size_t rowbase = smp ? (size_t)MP + b * 64 : (size_t)b * SEQ + c * 128;
    const int n = smp ? 64 : 128, nib = n >> 5;
    LAS unsigned char* vt = lds + g * GM_WAVE;
    {
        const int ch = lane & 7; const float* vg = P.in[I_VG] + l * 512 + g * 64 + ch * 8; const f32x4 g0 = *(const f32x4*)vg, g1 = *(const f32x4*)(vg + 4);
        for (int it = 0; it < n / 8; ++it) {
            const int j = it * 8 + (lane >> 3);
            const u32x4 raw = *(const u32x4*)(GV + (rowbase + j) * 512 + g * 64 + ch * 8);
            float x[8];
#pragma unroll
            for (int e = 0; e < 4; ++e) { x[2 * e] = __uint_as_float(raw[e] << 16); x[2 * e + 1] = __uint_as_float(raw[e] & 0xffff0000u); }
            float ss = 0.f;
#pragma unroll
            for (int e = 0; e < 8; ++e) ss += x[e] * x[e];
            ss += __shfl_xor(ss, 1); ss += __shfl_xor(ss, 2); ss += __shfl_xor(ss, 4);
            const float rstd = __builtin_amdgcn_rsqf(ss * (1.f / 64.f) + EPS);
#pragma unroll
            for (int e = 0; e < 4; ++e) { x[e] = x[e] * rstd * g0[e]; x[4 + e] = x[4 + e] * rstd * g1[e]; }
            if (smp) { float* o = P.out + O_SG + ((size_t)(l * 8 + b) * 64 + j) * 512 + g * 64 + ch * 8; *(f32x4*)o = (f32x4){x[0], x[1], x[2], x[3]}; *(f32x4*)(o + 4) = (f32x4){x[4], x[5], x[6], x[7]}; }
            LAS unsigned short* w = (LAS unsigned short*)(vt + (ch * 8) * GM_VSTRIDE + j * 2);
#pragma unroll
            for (int e = 0; e < 4; ++e) { const unsigned pk = cvt_pk_bf16(x[2 * e], x[2 * e + 1]); w[(2 * e) * (GM_VSTRIDE / 2)] = (unsigned short)(pk & 0xffffu); w[(2 * e + 1) * (GM_VSTRIDE / 2)] = (unsigned short)(pk >> 16); }
        }
        LDS_WAIT();
    }
    const float* gb = P.in[I_GB] + (size_t)(l * 8 + g) * 128;
    const float* gm = P.in[I_GOG] + l * 512;
#pragma unroll 1
    for (int ib = 0; ib < nib; ++ib) {
        f32x16 macc[2]; macc[0] = (f32x16){}; macc[1] = (f32x16){};
        const int i = 32 * ib + r32; const int nk = ib < 2 ? 4 : 8;
        const bf16_t* wp = Wg + (size_t)i * 128 + hi * 8;
#pragma unroll 4
        for (int ks = 0; ks < nk; ++ks) {
            const bf16x8 wf = *(const bf16x8*)(wp + ks * 16);
            const bf16x8 v0 = *(const LAS bf16x8*)(vt + r32 * GM_VSTRIDE + (16 * ks + 8 * hi) * 2), v1 = *(const LAS bf16x8*)(vt + (32 + r32) * GM_VSTRIDE + (16 * ks + 8 * hi) * 2);
            macc[0] = __builtin_amdgcn_mfma_f32_32x32x16_bf16(v0, wf, macc[0], 0, 0, 0); macc[1] = __builtin_amdgcn_mfma_f32_32x32x16_bf16(v1, wf, macc[1], 0, 0, 0);
        }
        const float bias = gb[i]; const bf16_t* up = U + (rowbase + i) * 512 + g * 64 + 4 * hi;
        float ss = 0.f;
#pragma unroll
        for (int db = 0; db < 2; ++db)
#pragma unroll
            for (int rq = 0; rq < 4; ++rq) { const u32x2 uu = *(const u32x2*)(up + 32 * db + 8 * rq);
                const float u0 = __uint_as_float(uu.x << 16), u1 = __uint_as_float(uu.x & 0xffff0000u), u2 = __uint_as_float(uu.y << 16), u3 = __uint_as_float(uu.y & 0xffff0000u);
                f32x16& a = macc[db];
                a[4 * rq] = (a[4 * rq] + bias) * u0; a[4 * rq + 1] = (a[4 * rq + 1] + bias) * u1; a[4 * rq + 2] = (a[4 * rq + 2] + bias) * u2; a[4 * rq + 3] = (a[4 * rq + 3] + bias) * u3;
                ss += (a[4 * rq] * a[4 * rq] + a[4 * rq + 1] * a[4 * rq + 1]) + (a[4 * rq + 2] * a[4 * rq + 2] + a[4 * rq + 3] * a[4 * rq + 3]); }
        ss += __shfl_xor(ss, 32);
        LAS float* SS = (LAS float*)(lds + GM_SS) + (ib & 1) * 256;
        if (hi == 0) SS[r32 * 8 + g] = ss;
        __syncthreads();
        const LAS f32x4* sp = (const LAS f32x4*)SS + r32 * 2; const f32x4 a = sp[0], bq = sp[1];
        const float tot = (a[0] + a[1]) + (a[2] + a[3]) + (bq[0] + bq[1]) + (bq[2] + bq[3]);
        store_t(AM + 512, rowbase + i, g * 64, hi, macc, __builtin_amdgcn_rsqf(tot * (1.f / 512.f) + EPS), gm);
    }
    __syncthreads();
}
__device__ __forceinline__ void fix_phase(const Params& P, int l, int G) {
    int tid_ = threadIdx.x; asm volatile("" : "+v"(tid_)); const int gt = blockIdx.x * NTHR + tid_, NGT = G * NTHR;
    const float* AL = (const float*)(P.ws + WS_AL); const float* AF = (const float*)(P.ws + WS_AF); const float* GF = (const float*)(P.ws + WS_GF); bf16_t* HM = (bf16_t*)(P.ws + WS_HM);
    const float* cw = P.in[I_CW] + (size_t)l * 3 * DFF; const float* cb = P.in[I_CB] + (size_t)l * DFF;
    for (int i = gt; i < 128 * DFF; i += NGT) {
        const int pm = i / DFF, col = i - pm * DFF;
        float l0 = 0.f, l1 = 0.f;
        if ((pm & 31) != 0) { l0 = AL[(size_t)((pm - 1) * 2) * DFF + col]; l1 = AL[(size_t)((pm - 1) * 2 + 1) * DFF + col]; }
        const float a0 = AF[(size_t)(pm * 2) * DFF + col], a1 = AF[(size_t)(pm * 2 + 1) * DFF + col], g0 = GF[(size_t)(pm * 2) * DFF + col], g1 = GF[(size_t)(pm * 2 + 1) * DFF + col];
        const float w0 = cw[col], w1 = cw[DFF + col], w2 = cw[2 * DFF + col], b = cb[col];
        const float h0 = pg8::gelu_t(b + w0 * l0 + w1 * l1 + w2 * a0) * g0, h1 = pg8::gelu_t(b + w0 * l1 + w1 * a0 + w2 * a1) * g1;
        HM[(size_t)(pm * 256) * DFF + col] = (bf16_t)(cvt_pk_bf16(h0, h0) & 0xffffu); HM[(size_t)(pm * 256 + 1) * DFF + col] = (bf16_t)(cvt_pk_bf16(h1, h1) & 0xffffu);
    }
}
#ifndef MK_MULTI
#define MK_MULTI 0
#endif
constexpr int PH_PER_LAYER = 6, N_PHASES = 2 + 2 * PH_PER_LAYER;

__global__ void __launch_bounds__(NTHR, 2) mega_fwd(Params P) {
    extern __shared__ __attribute__((aligned(16))) unsigned char lds_raw[];
    LAS unsigned char* lds = (LAS unsigned char*)lds_raw;
    const int G = gridDim.x;
    float* X = P.out;
    bf16_t* H = (bf16_t*)(P.ws + WS_H);
#if MK_MULTI
#define SEAM() do {} while (0)
#else
    cg::grid_group grid = cg::this_grid();
    unsigned* barw = (unsigned*)P.ws + CW_BAR;
    volatile LAS unsigned* barst = (volatile LAS unsigned*)(lds + LDS_BARST);
    if (blockIdx.x == 0) for (int i = threadIdx.x; i < XCD_BAR_WORDS; i += NTHR) __hip_atomic_store(barw + i, 0u, __ATOMIC_RELAXED, __HIP_MEMORY_SCOPE_AGENT);
    if (threadIdx.x < 2) barst[threadIdx.x] = 0u;
    __syncthreads();
    XcdBarrier bar; bar.bar = barw; bar.x = 0; bar.st = barst;
    bool bar_ready = false;
#define SEAM() do { if (!bar_ready) { grid.sync(); bar = xcd_barrier_post(barw, barst); bar_ready = true; } else xcd_barrier(bar); } while (0)
#endif
#define IN(k) (P.ph_lo <= (k) && (k) < P.ph_hi)
#define END(k) do { if ((k) + 1 < P.ph_hi) SEAM(); } while (0)
    if (IN(0)) { p0_prologue(P, lds, G); END(0); }
    float* ssb = (float*)(P.ws + WS_SS);
#pragma unroll 1
    for (int l = 0; l < 2; ++l) {
        const int pb = 1 + l * PH_PER_LAYER;
        const float* xp = l == 0 ? P.in[I_XP] : X; const float* xs = l == 0 ? P.in[I_XS] : X + (size_t)MP * DMODEL;
        if (IN(pb + 0)) {
            pg8::Gemm g{H, (const bf16_t*)(P.ws + WS_WIN) + (size_t)l * DIN * 1024, MT, DIN, 1024}; pg8::StaticOrder S; S.init(MT, DIN, G, (int)blockIdx.x);
            pg8::EpiIn E{(bf16_t*)(P.ws + WS_Q), (bf16_t*)(P.ws + WS_K), (bf16_t*)(P.ws + WS_V), (bf16_t*)(P.ws + WS_U), (bf16_t*)(P.ws + WS_GV),
                         P.out + O_PK + (size_t)l * 4 * 128 * 128, P.out + O_PV + (size_t)l * 4 * 128 * 128, P.out + O_SK + (size_t)l * 8 * 128 * 128, P.out + O_SV + (size_t)l * 8 * 128 * 128, ssb + (size_t)(2 * l) * MT};
            pg8::gemm_phase<pg8::EpiIn, pg8::StaticOrder, true, true>(lds, g, S, E);
            END(pb + 0);
        }
        if (IN(pb + 1)) {
            for (int it = blockIdx.x; it < 784; it += G) {
                if (it < 520) { const bool smp = it >= 512; attn_item(P, lds, l, smp, smp ? it - 512 : it >> 7, smp ? 0 : it & 127); }
                else { const bool smp = it >= 776; gmlp_item(P, lds, l, smp, smp ? it - 776 : (it - 520) >> 6, smp ? 0 : (it - 520) & 63); }
            }
            END(pb + 1);
        }
        if (IN(pb + 2)) {
            pg8::Gemm g{(const bf16_t*)(P.ws + WS_AM), (const bf16_t*)(P.ws + WS_WOUT) + (size_t)l * 1024 * 1024, MT, 1024, 1024}; pg8::StaticOrder S; S.init(MT, 1024, G, (int)blockIdx.x);
            pg8::EpiRes2 E{xp, xs, X, H, ssb + (size_t)(2 * l + 1) * MT};
            pg8::gemm_phase<pg8::EpiRes2, pg8::StaticOrder, true, true>(lds, g, S, E);
            END(pb + 2);
        }
        if (IN(pb + 3)) {
            pg8::Gemm g{H, (const bf16_t*)(P.ws + WS_WUG) + (size_t)l * 2 * DFF * 1024, MT, 2 * DFF, 1024}; pg8::StaticOrder S; S.init(MT, 2 * DFF, G, (int)blockIdx.x);
            pg8::EpiUG2 E{(bf16_t*)(P.ws + WS_HM), ssb + (size_t)(2 * l + 1) * MT, P.in[I_CW] + (size_t)l * 3 * DFF, P.in[I_CB] + (size_t)l * DFF, P.in[I_CC] + (size_t)l * 8 * 2 * DFF,
                          P.out + O_PC + (size_t)l * 4 * 2 * DFF, P.out + O_SC + (size_t)l * 8 * 2 * DFF, (float*)(P.ws + WS_AL), (float*)(P.ws + WS_AF), (float*)(P.ws + WS_GF), lds + 131072};
            pg8::gemm_phase<pg8::EpiUG2, pg8::StaticOrder, true, true>(lds, g, S, E);
            END(pb + 3);
        }
        if (IN(pb + 4)) { fix_phase(P, l, G); END(pb + 4); }
        if (IN(pb + 5)) {
            pg8::Gemm g{(const bf16_t*)(P.ws + WS_HM), (const bf16_t*)(P.ws + WS_WDN) + (size_t)l * 1024 * DFF, MT, 1024, DFF}; pg8::StaticOrder S; S.init(MT, 1024, G, (int)blockIdx.x);
            pg8::EpiRes2 E{X, X + (size_t)MP * DMODEL, X, H, ssb + (size_t)(2 * l + 2) * MT};
            pg8::gemm_phase<pg8::EpiRes2, pg8::StaticOrder, true, true>(lds, g, S, E);
            END(pb + 5);
        }
    }
    if (IN(N_PHASES - 1)) norm_rows<false>(X, X + (size_t)MP * DMODEL, P.in[I_FG], nullptr, X, G);
#undef IN
#undef END
#undef SEAM
}

extern "C" void kernel_launch(void* const* d_in, const int* in_sizes, int n_in, void* d_out, int out_size, void* d_ws, size_t ws_size, hipStream_t stream) {
    static int grid = 0;
    if (grid == 0) {
        int dev = 0, cus = 0, per_cu = 0;
        if (n_in != 21 || ws_size < WS_END) { fprintf(stderr, "kernel_launch: unexpected n_in %d / ws_size %zu (need %zu)\n", n_in, ws_size, (size_t)WS_END); grid = -1; return; }
        hipGetDevice(&dev); hipDeviceGetAttribute(&cus, hipDeviceAttributeMultiprocessorCount, dev);
        if (hipFuncSetAttribute((const void*)mega_fwd, hipFuncAttributeMaxDynamicSharedMemorySize, LDS_BYTES) != hipSuccess) { fprintf(stderr, "kernel_launch: hipFuncSetAttribute failed\n"); grid = -1; return; }
        if (hipOccupancyMaxActiveBlocksPerMultiprocessor(&per_cu, (const void*)mega_fwd, NTHR, LDS_BYTES) != hipSuccess || per_cu < 1) { fprintf(stderr, "kernel_launch: occupancy query says %d\n", per_cu); per_cu = 1; }
        (void)hipGetLastError();
        grid = cus * per_cu;
        fprintf(stderr, "kernel_launch: grid %d (cus %d x %d)\n", grid, cus, per_cu);
    }
    if (grid < 0) return;
    Params p{};
    for (int i = 0; i < 21; ++i) p.in[i] = (const float*)d_in[i];
    p.out = (float*)d_out; p.ws = (unsigned char*)d_ws;
#if MK_MULTI
    for (int k = 0; k < N_PHASES; ++k) { p.ph_lo = k; p.ph_hi = k + 1; hipLaunchKernelGGL(mega_fwd, dim3(grid), dim3(NTHR), LDS_BYTES, stream, p); }
#else
    p.ph_lo = 0; p.ph_hi = N_PHASES;
    void* args[] = {&p};
    hipError_t e = hipLaunchCooperativeKernel((const void*)mega_fwd, dim3(grid), dim3(NTHR), args, LDS_BYTES, stream);
    if (e != hipSuccess) fprintf(stderr, "kernel_launch: cooperative launch failed: %s (grid %d)\n", hipGetErrorString(e), grid);
#endif
}
```
